# Optimizing an MI355X kernel written in HIP

```python
import jax, jax.numpy as jnp
from jax import lax
import numpy as np

D_MODEL = 1024
BATCH = 2
SEQ = 8192
DEPTH = 1

GRID_W = 64
CTX_LEN = 256

RET_HEADS = 4
RET_QK_DIM = 128
RET_V_DIM = 256
RET_CHUNK = 128
ROPE_THETA = 10000.0
RET_QK_W = RET_HEADS * RET_QK_DIM
RET_V_W = RET_HEADS * RET_V_DIM

SGU_GROUPS = 4
SGU_CHUNK = 128
SGU_WIDTH = 1024

N_EXPERTS = 16
EC_CAPACITY_FACTOR = 2
D_EXPERT = 1024

LN_EPS = 1e-6
DEEPNORM_ALPHA = (2.0 * DEPTH) ** 0.25
DEEPNORM_BETA = (8.0 * DEPTH) ** -0.25

IN_WIDTHS = (RET_QK_W, RET_QK_W, RET_V_W, RET_V_W, SGU_WIDTH, SGU_WIDTH, D_MODEL, D_MODEL)
IN_OFFSETS = tuple(sum(IN_WIDTHS[:i + 1]) for i in range(len(IN_WIDTHS) - 1))
D_IN = sum(IN_WIDTHS)

kernel_name = "hybrid_retention_sgu_ecmoe_dit"


def layer_norm(x, w=None, b=None):
    xf = x.astype(jnp.float32)
    mu = jnp.mean(xf, axis=-1, keepdims=True)
    var = jnp.mean(jnp.square(xf - mu), axis=-1, keepdims=True)
    y = (xf - mu) * lax.rsqrt(var + LN_EPS)
    if w is not None:
        y = y * w.astype(jnp.float32) + b.astype(jnp.float32)
    return y.astype(x.dtype)


def modulate(x, shift, scale):
    return layer_norm(x) * (1.0 + scale) + shift


def axial_rope_tables(n_tokens, dtype):
    rows = n_tokens // GRID_W
    r, col = jnp.meshgrid(jnp.arange(rows), jnp.arange(GRID_W), indexing="ij")
    n_freq = RET_QK_DIM // 4
    inv = ROPE_THETA ** (-jnp.arange(n_freq, dtype=jnp.float32) / n_freq)
    pos = jnp.stack([r.reshape(-1), col.reshape(-1)], axis=-1).astype(jnp.float32)
    ang = pos[..., None] * inv
    return jnp.cos(ang).astype(dtype), jnp.sin(ang).astype(dtype)


def apply_axial_rope(x, cos, sin):
    bsz, t, nh, dk = x.shape
    xs = x.reshape(bsz, t, nh, 2, 2, dk // 4)
    x1, x2 = xs[..., 0, :], xs[..., 1, :]
    c, s = cos[:, None], sin[:, None]
    return jnp.stack([x1 * c - x2 * s, x2 * c + x1 * s], axis=-2).reshape(bsz, t, nh, dk)


def split_heads(z, nh):
    bsz, t, _ = z.shape
    return z.reshape(bsz, t, nh, -1).transpose(0, 2, 1, 3)


def retention_chunked(q, k, v, log_gamma, state0):
    bsz, nh, t, dk = q.shape
    dv = v.shape[-1]
    n = t // RET_CHUNK
    q = q.reshape(bsz, nh, n, RET_CHUNK, dk)
    k = k.reshape(bsz, nh, n, RET_CHUNK, dk)
    v = v.reshape(bsz, nh, n, RET_CHUNK, dv)
    idx = jnp.arange(RET_CHUNK, dtype=jnp.float32)
    diff = idx[:, None] - idx[None, :]
    decay_mask = jnp.where(diff[None] >= 0, jnp.exp(diff[None] * log_gamma[:, None, None]), 0.0)
    scores = jnp.einsum("bhnld,bhnmd->bhnlm", q, k) * decay_mask[None, :, None].astype(q.dtype)
    intra = jnp.einsum("bhnlm,bhnmv->bhnlv", scores, v)
    zeta = jnp.exp((RET_CHUNK - 1 - idx)[None] * log_gamma[:, None])
    xi = jnp.exp((idx + 1.0)[None] * log_gamma[:, None])
    chunk_kv = jnp.einsum("bhnld,bhnlv->nbhdv", k * zeta[None, :, None, :, None], v).astype(jnp.float32)
    chunk_decay = jnp.exp(RET_CHUNK * log_gamma)[None, :, None, None]

    def step(state, kv):
        return chunk_decay * state + kv, state

    state_final, state_prev = lax.scan(step, state0, chunk_kv)
    cross = jnp.einsum("bhnld,nbhdv->bhnlv", q * xi[None, :, None, :, None], state_prev)
    out = (intra + cross).reshape(bsz, nh, t, dv)
    return out, state_final


def retention_final_state(k, v, log_gamma):
    t = k.shape[2]
    w = jnp.exp((t - 1 - jnp.arange(t, dtype=jnp.float32))[None] * log_gamma[:, None])
    return jnp.einsum("bhtd,bhtv->bhdv", k * w[None, :, :, None], v).astype(jnp.float32)


def context_retention_states(hc, w_in, b_in, decay_f, decay_b):
    lo, hi = RET_QK_W, 2 * RET_QK_W + RET_V_W
    kv = hc @ w_in[:, lo:hi] + b_in[lo:hi]
    k, v = jnp.split(kv, [RET_QK_W], axis=-1)
    k = split_heads(k, RET_HEADS) * (RET_QK_DIM ** -0.5)
    v = split_heads(v, RET_HEADS)
    sf = retention_final_state(k, v, jax.nn.log_sigmoid(decay_f.astype(jnp.float32)))
    sb = retention_final_state(jnp.flip(k, axis=2), jnp.flip(v, axis=2),
                               jax.nn.log_sigmoid(decay_b.astype(jnp.float32)))
    return sf, sb


def token_mixer(h, rope, s0f, s0b, w_in, b_in, decay_f, decay_b, gn_w, gn_b,
                sgu_ln_w, sgu_ln_b, sgu_w, sgu_b, w_pa, w_pb, w_o, b_o):
    bsz, t, _ = h.shape
    z = h @ w_in + b_in
    q, k, v, g, u, vs, ga, gb = jnp.split(z, IN_OFFSETS, axis=-1)

    q = q.reshape(bsz, t, RET_HEADS, RET_QK_DIM)
    k = k.reshape(bsz, t, RET_HEADS, RET_QK_DIM) * (RET_QK_DIM ** -0.5)
    if rope is not None:
        q = apply_axial_rope(q, *rope)
        k = apply_axial_rope(k, *rope)
    q = q.transpose(0, 2, 1, 3)
    k = k.transpose(0, 2, 1, 3)
    v = split_heads(v, RET_HEADS)
    lgf = jax.nn.log_sigmoid(decay_f.astype(jnp.float32))
    lgb = jax.nn.log_sigmoid(decay_b.astype(jnp.float32))
    o_f, sf = retention_chunked(q, k, v, lgf, s0f)
    o_b, sb = retention_chunked(jnp.flip(q, axis=2), jnp.flip(k, axis=2), jnp.flip(v, axis=2), lgb, s0b)
    o = (o_f + jnp.flip(o_b, axis=2)).transpose(0, 2, 1, 3)
    o = layer_norm(o).reshape(bsz, t, RET_V_W) * gn_w + gn_b
    ret = o.astype(h.dtype) * jax.nn.silu(g)

    u = jax.nn.gelu(u)
    vs = layer_norm(jax.nn.gelu(vs), sgu_ln_w, sgu_ln_b)
    vs = vs.reshape(bsz, t // SGU_CHUNK, SGU_CHUNK, SGU_GROUPS, SGU_WIDTH // SGU_GROUPS)
    spatial = jnp.einsum("gpq,bnqgc->bnpgc", sgu_w, vs) + sgu_b.T[None, None, :, :, None]
    sgu = u * spatial.reshape(bsz, t, SGU_WIDTH)

    y = jax.nn.sigmoid(ga) * (ret @ w_pa) + jax.nn.sigmoid(gb) * (sgu @ w_pb)
    return y @ w_o + b_o, sf, sb


def expert_choice_ffn(h, w_router, b_router, w_gate, w_up, w_down):
    bsz, t, d = h.shape
    cap = EC_CAPACITY_FACTOR * t // N_EXPERTS
    logits = (h @ w_router + b_router).astype(jnp.float32)
    affinity = jax.nn.softmax(logits, axis=-1)
    gates, idx = lax.top_k(affinity.transpose(0, 2, 1), cap)
    xs = jax.vmap(lambda hb, ib: hb[ib])(h, idx)
    hidden = jax.nn.silu(jnp.einsum("becd,edf->becf", xs, w_gate)) * jnp.einsum("becd,edf->becf", xs, w_up)
    ye = jnp.einsum("becf,efd->becd", hidden, w_down) * gates[..., None].astype(h.dtype)
    return jax.vmap(lambda yb, ib: jnp.zeros((t, d), yb.dtype).at[ib.reshape(-1)].add(yb.reshape(-1, d)))(ye, idx)


def setup_inputs(seed: int = 0) -> dict:
    key = jax.random.key(seed)
    ks = jax.random.split(key, 32)
    f32 = jnp.float32
    L, D = DEPTH, D_MODEL

    def nrm(k, shape, scale):
        return jax.random.normal(k, shape, f32) * scale

    base_decay = jnp.log(2.0 ** (5.0 + jnp.arange(RET_HEADS, dtype=f32)) - 1.0)
    return {
        "x": nrm(ks[0], (BATCH, SEQ, D), 1.0),
        "c": nrm(ks[1], (BATCH, D), 1.0),
        "ctx": nrm(ks[2], (BATCH, CTX_LEN, D), 1.0),
        "c_ctx": nrm(ks[3], (D,), 1.0),
        "w_ada": nrm(ks[4], (L, D, 6 * D), 0.5 * D ** -0.5),
        "b_ada": nrm(ks[5], (L, 6 * D), 0.02),
        "w_in": nrm(ks[6], (L, D, D_IN), D ** -0.5),
        "b_in": nrm(ks[7], (L, D_IN), 0.02),
        "ret_decay_f": base_decay[None] + nrm(ks[8], (L, RET_HEADS), 0.1),
        "ret_decay_b": base_decay[None] + nrm(ks[9], (L, RET_HEADS), 0.1),
        "ret_gn_w": 1.0 + nrm(ks[10], (L, RET_V_W), 0.02),
        "ret_gn_b": nrm(ks[11], (L, RET_V_W), 0.02),
        "sgu_ln_w": 1.0 + nrm(ks[12], (L, SGU_WIDTH), 0.02),
        "sgu_ln_b": nrm(ks[13], (L, SGU_WIDTH), 0.02),
        "sgu_w": nrm(ks[14], (L, SGU_GROUPS, SGU_CHUNK, SGU_CHUNK), SGU_CHUNK ** -0.5),
        "sgu_b": 1.0 + nrm(ks[15], (L, SGU_GROUPS, SGU_CHUNK), 0.02),
        "w_pa": nrm(ks[16], (L, RET_V_W, D), DEEPNORM_BETA * RET_V_W ** -0.5),
        "w_pb": nrm(ks[17], (L, SGU_WIDTH, D), DEEPNORM_BETA * SGU_WIDTH ** -0.5),
        "w_o": nrm(ks[18], (L, D, D), DEEPNORM_BETA * D ** -0.5),
        "b_o": nrm(ks[19], (L, D), 0.02),
        "ln1_w": 1.0 + nrm(ks[20], (L, D), 0.02),
        "ln1_b": nrm(ks[21], (L, D), 0.02),
        "w_router": nrm(ks[22], (L, D, N_EXPERTS), D ** -0.5),
        "b_router": nrm(ks[23], (L, N_EXPERTS), 0.01),
        "w_gate": nrm(ks[24], (L, N_EXPERTS, D, D_EXPERT), D ** -0.5),
        "w_up": nrm(ks[25], (L, N_EXPERTS, D, D_EXPERT), D ** -0.5),
        "w_down": nrm(ks[26], (L, N_EXPERTS, D_EXPERT, D), DEEPNORM_BETA * D_EXPERT ** -0.5),
        "ln2_w": 1.0 + nrm(ks[27], (L, D), 0.02),
        "ln2_b": nrm(ks[28], (L, D), 0.02),
    }


def reference(x, c, ctx, c_ctx, w_ada, b_ada, w_in, b_in, ret_decay_f, ret_decay_b, ret_gn_w, ret_gn_b,
              sgu_ln_w, sgu_ln_b, sgu_w, sgu_b, w_pa, w_pb, w_o, b_o, ln1_w, ln1_b,
              w_router, b_router, w_gate, w_up, w_down, ln2_w, ln2_b):
    bsz, n_tok, _ = x.shape
    rope = axial_rope_tables(n_tok, x.dtype)
    zero_state = jnp.zeros((bsz, RET_HEADS, RET_QK_DIM, RET_V_DIM), jnp.float32)

    for l in range(DEPTH):
        mod = jax.nn.silu(c) @ w_ada[l] + b_ada[l]
        mod_ctx = jax.nn.silu(c_ctx) @ w_ada[l] + b_ada[l]
        sh1, sc1, g1, sh2, sc2, g2 = jnp.split(mod[:, None, :], 6, axis=-1)
        csh1, csc1, cg1, csh2, csc2, cg2 = jnp.split(mod_ctx[None, None, :], 6, axis=-1)
        mixer_params = (w_in[l], b_in[l], ret_decay_f[l], ret_decay_b[l], ret_gn_w[l], ret_gn_b[l],
                        sgu_ln_w[l], sgu_ln_b[l], sgu_w[l], sgu_b[l], w_pa[l], w_pb[l], w_o[l], b_o[l])
        moe_params = (w_router[l], b_router[l], w_gate[l], w_up[l], w_down[l])
        last = (l + 1 == DEPTH)

        hc = modulate(ctx, csh1, csc1)
        if last:
            sf, sb = context_retention_states(hc, w_in[l], b_in[l], ret_decay_f[l], ret_decay_b[l])
        else:
            mix_c, sf, sb = token_mixer(hc, None, zero_state, zero_state, *mixer_params)

        h = modulate(x, sh1, sc1)
        mix, _, _ = token_mixer(h, rope, sf, sb, *mixer_params)
        x = layer_norm(DEEPNORM_ALPHA * x + g1 * mix, ln1_w[l], ln1_b[l])
        x = layer_norm(DEEPNORM_ALPHA * x + g2 * expert_choice_ffn(modulate(x, sh2, sc2), *moe_params),
                       ln2_w[l], ln2_b[l])

        if not last:
            ctx = layer_norm(DEEPNORM_ALPHA * ctx + cg1 * mix_c, ln1_w[l], ln1_b[l])
            ctx = layer_norm(DEEPNORM_ALPHA * ctx + cg2 * expert_choice_ffn(modulate(ctx, csh2, csc2), *moe_params),
                             ln2_w[l], ln2_b[l])
    return x
```

```cpp
#include <hip/hip_runtime.h>
#include <cstdio>
#include <cstdint>

namespace nv {
constexpr int D = 1024, B = 2, T = 8192, CTX = 256, DIN = 7168, NE = 16, CAP = 1024;
constexpr float LN_EPS = 1e-6f, ALPHA = 1.189207115002721f, KSCALE = 0.08838834764831845f;
constexpr int ZQ = 0, ZK = 512, ZV = 1024, ZG = 2048, ZU = 3072, ZVS = 4096, ZGA = 5120, ZGB = 6144;

__device__ __forceinline__ float wave_sum(float v) {
#pragma unroll
  for (int o = 1; o < 64; o <<= 1) v += __shfl_xor(v, o);
  return v;
}
__device__ __forceinline__ float sigmoidf_(float x) { return 1.f / (1.f + expf(-x)); }
__device__ __forceinline__ float siluf_(float x) { return x * sigmoidf_(x); }
__device__ __forceinline__ float geluf_(float x) { return 0.5f * x * (1.f + tanhf(0.7978845608028654f * (x + 0.044715f * x * x * x))); }

__global__ void k_mod(const float* c, const float* cctx, const float* w_ada, const float* b_ada, float* mod) {
  int n = blockIdx.x * blockDim.x + threadIdx.x; int r = blockIdx.y;
  if (n >= 6 * D) return;
  const float* cv = r < 2 ? c + r * D : cctx;
  float acc = 0.f;
  for (int k = 0; k < D; ++k) acc += siluf_(cv[k]) * w_ada[(size_t)k * 6 * D + n];
  mod[r * 6 * D + n] = acc + b_ada[n];
}

__global__ void k_rowln(const float* xin, const float* add, const float* gate, const float* lw, const float* lb,
                        float* out1, const float* sh, const float* sc, float* out2, float alpha, int rows) {
  int row = (blockIdx.x * blockDim.x + threadIdx.x) >> 6; int lane = threadIdx.x & 63;
  if (row >= rows) return;
  float v[16]; float s = 0.f;
#pragma unroll
  for (int i = 0; i < 16; ++i) { int cidx = lane + 64 * i; float t = alpha * xin[(size_t)row * D + cidx]; if (add) t += gate[cidx] * add[(size_t)row * D + cidx]; v[i] = t; s += t; }
  float mean = wave_sum(s) * (1.f / D); float q = 0.f;
#pragma unroll
  for (int i = 0; i < 16; ++i) { v[i] -= mean; q += v[i] * v[i]; }
  float rstd = rsqrtf(wave_sum(q) * (1.f / D) + LN_EPS);
#pragma unroll
  for (int i = 0; i < 16; ++i) { int cidx = lane + 64 * i; float y = v[i] * rstd; if (lw) y = y * lw[cidx] + lb[cidx];
    if (out1) out1[(size_t)row * D + cidx] = y; if (out2) out2[(size_t)row * D + cidx] = y * (1.f + sc[cidx]) + sh[cidx]; }
}

struct EpiStore { float* C; int ldc; int pad; const float* bias; long cBatch;
  __device__ void operator()(int z, int m, int n, float v) const { C[z * cBatch + (size_t)m * ldc + n] = v + (bias ? bias[n] : 0.f); } };
struct EpiGate { float* Y; const float* Z; int zoff; int accumulate;
  __device__ void operator()(int z, int m, int n, float v) const { float g = sigmoidf_(Z[(size_t)m * DIN + zoff + n]); float r = g * v; if (accumulate) r += Y[(size_t)m * D + n]; Y[(size_t)m * D + n] = r; } };

template <class Epi>
__global__ __launch_bounds__(256) void ngemm(const float* __restrict__ A, const int* __restrict__ gidx, const float* __restrict__ Bm,
                                             long aBatch, long bBatch, Epi epi, int lda, int ldb, int K, int gBatch) {
  __shared__ float As[16][68];
  __shared__ float Bs[16][68];
  const int z = blockIdx.z; A += z * aBatch; Bm += z * bBatch; if (gidx) gidx += z * gBatch;
  const int tid = threadIdx.x, tx = tid & 15, ty = tid >> 4;
  const int m0 = blockIdx.y * 64, n0 = blockIdx.x * 64;
  float acc[4][4];
#pragma unroll
  for (int i = 0; i < 4; ++i)
#pragma unroll
    for (int j = 0; j < 4; ++j) acc[i][j] = 0.f;
  const int ar = tid >> 2, ak = (tid & 3) * 4;
  const long arow = gidx ? (long)gidx[m0 + ar] : (long)(m0 + ar);
  const float* ap = A + arow * lda + ak;
  const int bk = tid >> 4, bn = (tid & 15) * 4;
  const float* bp = Bm + (long)bk * ldb + n0 + bn;
  for (int k0 = 0; k0 < K; k0 += 16) {
    const float4 av = *(const float4*)(ap + k0);
    const float4 bv = *(const float4*)(bp + (long)k0 * ldb);
    As[ak + 0][ar] = av.x; As[ak + 1][ar] = av.y; As[ak + 2][ar] = av.z; As[ak + 3][ar] = av.w;
    *(float4*)&Bs[bk][bn] = bv;
    __syncthreads();
#pragma unroll
    for (int kk = 0; kk < 16; ++kk) {
      const float4 a = *(const float4*)&As[kk][ty * 4]; const float4 b = *(const float4*)&Bs[kk][tx * 4];
      const float aa[4] = {a.x, a.y, a.z, a.w}; const float bb[4] = {b.x, b.y, b.z, b.w};
#pragma unroll
      for (int i = 0; i < 4; ++i)
#pragma unroll
        for (int j = 0; j < 4; ++j) acc[i][j] += aa[i] * bb[j];
    }
    __syncthreads();
  }
#pragma unroll
  for (int i = 0; i < 4; ++i)
#pragma unroll
    for (int j = 0; j < 4; ++j) epi(z, m0 + ty * 4 + i, n0 + tx * 4 + j, acc[i][j]);
}

__global__ void k_ctx_state(const float* kvc, const float* decf, const float* decb, float* S0) {
  int idx = blockIdx.x * blockDim.x + threadIdx.x;
  int v = idx & 255, d = (idx >> 8) & 127, h = (idx >> 15) & 3, b = (idx >> 17) & 1, dir = idx >> 18;
  if (dir >= 2) return;
  float dec = dir == 0 ? decf[h] : decb[h]; float lg = -log1pf(expf(-dec));
  float acc = 0.f;
  for (int t = 0; t < CTX; ++t) {
    float w = expf((dir == 0 ? (float)(CTX - 1 - t) : (float)t) * lg);
    const float* r = kvc + (size_t)(b * CTX + t) * 1536;
    acc += w * (r[h * 128 + d] * KSCALE) * r[512 + h * 256 + v];
  }
  S0[idx] = acc;
}

__global__ void k_rope(float* Z) {
  int idx = blockIdx.x * blockDim.x + threadIdx.x;
  int f = idx & 31, a = (idx >> 5) & 1, h = (idx >> 6) & 3, sec = (idx >> 8) & 1, t = idx >> 9;
  if (t >= T) return;
  float pos = a == 0 ? (float)(t / 64) : (float)(t % 64);
  float inv = powf(10000.f, -(float)f / 32.f);
  float ang = pos * inv; float cs = cosf(ang), sn = sinf(ang);
  float* p = Z + (size_t)t * DIN + (sec ? ZK : ZQ) + h * 128 + a * 64 + f;
  float x1 = p[0], x2 = p[32]; float scl = sec ? KSCALE : 1.f;
  p[0] = (x1 * cs - x2 * sn) * scl; p[32] = (x2 * cs + x1 * sn) * scl;
}

__global__ __launch_bounds__(256) void k_ret_rec(const float* Z, const float* S0  , const float* decf, const float* decb, float* OF, float* OB, int b, int pad) {
  __shared__ float qs[32][128]; __shared__ float ks[32][128];
  int h = blockIdx.x & 3, dir = blockIdx.x >> 2; int j = threadIdx.x;
  float dec = dir == 0 ? decf[h] : decb[h]; float gamma = 1.f / (1.f + expf(-dec));
  float S[128];
  const float* s0 = S0 + ((size_t)((dir * 2 + b) * 4 + h) * 128) * 256;
#pragma unroll
  for (int d = 0; d < 128; ++d) S[d] = s0[d * 256 + j];
  float* O = dir == 0 ? OF : OB;
  for (int blk = 0; blk < T / 32; ++blk) {
    int tb = dir == 0 ? blk * 32 : T - 32 - blk * 32;
    __syncthreads();
    for (int i = threadIdx.x; i < 32 * 128; i += 256) { int tt = i >> 7, d = i & 127; qs[tt][d] = Z[(size_t)(tb + tt) * DIN + ZQ + h * 128 + d]; ks[tt][d] = Z[(size_t)(tb + tt) * DIN + ZK + h * 128 + d]; }
    __syncthreads();
    for (int s = 0; s < 32; ++s) {
      int tt = dir == 0 ? s : 31 - s; int t = tb + tt;
      float vj = Z[(size_t)t * DIN + ZV + h * 256 + j];
      float o = 0.f;
#pragma unroll
      for (int d = 0; d < 128; ++d) { S[d] = gamma * S[d] + ks[tt][d] * vj; o += qs[tt][d] * S[d]; }
      O[(size_t)t * D + h * 256 + j] = o;
    }
  }
}

__global__ void k_ret_fin(const float* OF, const float* OB, const float* Z, const float* gw, const float* gb, float* RET) {
  int w = (blockIdx.x * blockDim.x + threadIdx.x) >> 6; int lane = threadIdx.x & 63;
  if (w >= T * 4) return; int t = w >> 2, h = w & 3;
  float v[4]; float s = 0.f;
#pragma unroll
  for (int i = 0; i < 4; ++i) { int cidx = h * 256 + lane + 64 * i; v[i] = OF[(size_t)t * D + cidx] + OB[(size_t)t * D + cidx]; s += v[i]; }
  float mean = wave_sum(s) * (1.f / 256); float q = 0.f;
#pragma unroll
  for (int i = 0; i < 4; ++i) { v[i] -= mean; q += v[i] * v[i]; }
  float rstd = rsqrtf(wave_sum(q) * (1.f / 256) + LN_EPS);
#pragma unroll
  for (int i = 0; i < 4; ++i) { int cidx = h * 256 + lane + 64 * i; float y = v[i] * rstd * gw[cidx] + gb[cidx]; RET[(size_t)t * D + cidx] = y * siluf_(Z[(size_t)t * DIN + ZG + cidx]); }
}

__global__ void k_gv(const float* Z, const float* lw, const float* lb, float* GV) {
  int row = (blockIdx.x * blockDim.x + threadIdx.x) >> 6; int lane = threadIdx.x & 63;
  if (row >= T) return;
  float v[16]; float s = 0.f;
#pragma unroll
  for (int i = 0; i < 16; ++i) { v[i] = geluf_(Z[(size_t)row * DIN + ZVS + lane + 64 * i]); s += v[i]; }
  float mean = wave_sum(s) * (1.f / D); float q = 0.f;
#pragma unroll
  for (int i = 0; i < 16; ++i) { v[i] -= mean; q += v[i] * v[i]; }
  float rstd = rsqrtf(wave_sum(q) * (1.f / D) + LN_EPS);
#pragma unroll
  for (int i = 0; i < 16; ++i) { int cidx = lane + 64 * i; GV[(size_t)row * D + cidx] = v[i] * rstd * lw[cidx] + lb[cidx]; }
}
__global__ void k_sgu(const float* Z, const float* GV, const float* sw, const float* sb, float* SGU) {
  int idx = blockIdx.x * blockDim.x + threadIdx.x; int ch = idx & 1023, t = idx >> 10;
  if (t >= T) return; int n = t >> 7, p = t & 127, g = ch >> 8;
  const float* wrow = sw + ((size_t)g * 128 + p) * 128; float acc = 0.f;
  for (int q = 0; q < 128; ++q) acc += wrow[q] * GV[(size_t)(n * 128 + q) * D + ch];
  acc += sb[g * 128 + p];
  SGU[(size_t)t * D + ch] = geluf_(Z[(size_t)t * DIN + ZU + ch]) * acc;
}

__global__ void k_router(const float* H2, const float* wr, const float* br, float* AFF) {
  int row = (blockIdx.x * blockDim.x + threadIdx.x) >> 6; int lane = threadIdx.x & 63;
  if (row >= T) return;
  float acc[NE];
#pragma unroll
  for (int e = 0; e < NE; ++e) acc[e] = 0.f;
  for (int i = 0; i < 16; ++i) { int k = lane + 64 * i; float hv = H2[(size_t)row * D + k];
#pragma unroll
    for (int e = 0; e < NE; ++e) acc[e] += hv * wr[k * NE + e]; }
  float mx = -1e30f;
#pragma unroll
  for (int e = 0; e < NE; ++e) { acc[e] = wave_sum(acc[e]) + br[e]; mx = fmaxf(mx, acc[e]); }
  float sum = 0.f;
#pragma unroll
  for (int e = 0; e < NE; ++e) { acc[e] = expf(acc[e] - mx); sum += acc[e]; }
  if (lane < NE) { float o = 0.f;
#pragma unroll
    for (int e = 0; e < NE; ++e) if (e == lane) o = acc[e];
    AFF[(size_t)row * NE + lane] = o / sum; }
}
__global__ void k_topk(const float* AFF, int* IDX, float* GATE) {
  int idx = blockIdx.x * blockDim.x + threadIdx.x; int t = idx & (T - 1), e = idx >> 13;
  if (e >= NE) return;
  float a = AFF[(size_t)t * NE + e]; int rank = 0;
  for (int s = 0; s < T; ++s) { float o = AFF[(size_t)s * NE + e]; rank += (o > a) || (o == a && s < t); }
  if (rank < CAP) { IDX[e * CAP + rank] = t; GATE[e * CAP + rank] = a; }
}
__global__ void k_hidden(float* G1, const float* U1, size_t n) { size_t i = (size_t)blockIdx.x * blockDim.x + threadIdx.x; if (i < n) G1[i] = siluf_(G1[i]) * U1[i]; }
__global__ void k_zero(float* p, size_t n) { size_t i = (size_t)blockIdx.x * blockDim.x + threadIdx.x; if (i < n) p[i] = 0.f; }
__global__ void k_scatter(const float* YE, const int* IDX, const float* GATE, float* MOE) {
  size_t i = (size_t)blockIdx.x * blockDim.x + threadIdx.x; if (i >= (size_t)NE * CAP * D) return;
  int d = i & 1023; int es = i >> 10; atomicAdd(&MOE[(size_t)IDX[es] * D + d], YE[i] * GATE[es]);
}
}

extern "C" void kernel_launch(void* const* d_in, const int* in_sizes, int n_in, void* d_out, int out_size, void* d_ws, size_t ws_size, hipStream_t stream) {
  using namespace nv;
  const float* x = (const float*)d_in[0]; const float* c = (const float*)d_in[1]; const float* ctx = (const float*)d_in[2]; const float* c_ctx = (const float*)d_in[3];
  const float* w_ada = (const float*)d_in[4]; const float* b_ada = (const float*)d_in[5]; const float* w_in = (const float*)d_in[6]; const float* b_in = (const float*)d_in[7];
  const float* decf = (const float*)d_in[8]; const float* decb = (const float*)d_in[9]; const float* gn_w = (const float*)d_in[10]; const float* gn_b = (const float*)d_in[11];
  const float* sln_w = (const float*)d_in[12]; const float* sln_b = (const float*)d_in[13]; const float* sgu_w = (const float*)d_in[14]; const float* sgu_b = (const float*)d_in[15];
  const float* w_pa = (const float*)d_in[16]; const float* w_pb = (const float*)d_in[17]; const float* w_o = (const float*)d_in[18]; const float* b_o = (const float*)d_in[19];
  const float* ln1_w = (const float*)d_in[20]; const float* ln1_b = (const float*)d_in[21]; const float* w_router = (const float*)d_in[22]; const float* b_router = (const float*)d_in[23];
  const float* w_gate = (const float*)d_in[24]; const float* w_up = (const float*)d_in[25]; const float* w_down = (const float*)d_in[26]; const float* ln2_w = (const float*)d_in[27]; const float* ln2_b = (const float*)d_in[28];
  float* out = (float*)d_out;
  const size_t MiB = 1u << 20;
  char* ws = (char*)d_ws;
  float* Z = (float*)(ws);
  float* R1 = (float*)(ws + 224 * MiB);
  float* R2 = (float*)(ws + 256 * MiB);
  char* sm = ws + 288 * MiB;
  float* MOD = (float*)(sm);
  float* HC = (float*)(sm + 1 * MiB);
  float* KVC = (float*)(sm + 3 * MiB);
  float* S0 = (float*)(sm + 6 * MiB);
  float* AFF = (float*)(sm + 8 * MiB);
  int* IDX = (int*)(sm + 9 * MiB); float* GATE = (float*)(sm + 10 * MiB);
  if (ws_size < 300 * MiB) { fprintf(stderr, "ws too small\n"); return; }

  k_mod<<<dim3(6 * D / 256, 3), 256, 0, stream>>>(c, c_ctx, w_ada, b_ada, MOD);
  k_rowln<<<B * CTX / 4, 256, 0, stream>>>(ctx, nullptr, nullptr, nullptr, nullptr, nullptr, MOD + 2 * 6 * D + 0, MOD + 2 * 6 * D + D, HC, 1.f, B * CTX);
  ngemm<EpiStore><<<dim3(1536 / 64, B * CTX / 64, 1), 256, 0, stream>>>(HC, nullptr, w_in + 512, 0, 0, EpiStore{KVC, 1536, 0, b_in + 512, 0}, D, DIN, D, 0);
  k_ctx_state<<<2 * 2 * 4 * 128 * 256 / 256, 256, 0, stream>>>(KVC, decf, decb, S0);
  for (int b = 0; b < B; ++b) {
    const float* xb = x + (size_t)b * T * D; float* ob = out + (size_t)b * T * D; const float* mb = MOD + b * 6 * D;
    const float *sh1 = mb, *sc1 = mb + D, *g1 = mb + 2 * D, *sh2 = mb + 3 * D, *sc2 = mb + 4 * D, *g2 = mb + 5 * D;
    k_rowln<<<T / 4, 256, 0, stream>>>(xb, nullptr, nullptr, nullptr, nullptr, nullptr, sh1, sc1, R1, 1.f, T);
    ngemm<EpiStore><<<dim3(DIN / 64, T / 64, 1), 256, 0, stream>>>(R1, nullptr, w_in, 0, 0, EpiStore{Z, DIN, 0, b_in, 0}, D, DIN, D, 0);
    k_rope<<<T * 512 / 256, 256, 0, stream>>>(Z);
    k_ret_rec<<<8, 256, 0, stream>>>(Z, S0, decf, decb, R1, R2, b, 0);
    k_ret_fin<<<T * 4 / 4, 256, 0, stream>>>(R1, R2, Z, gn_w, gn_b, R1);
    k_gv<<<T / 4, 256, 0, stream>>>(Z, sln_w, sln_b, ob);
    k_sgu<<<T * D / 256, 256, 0, stream>>>(Z, ob, sgu_w, sgu_b, R2);
    ngemm<EpiGate><<<dim3(D / 64, T / 64, 1), 256, 0, stream>>>(R1, nullptr, w_pa, 0, 0, EpiGate{ob, Z, ZGA, 0}, D, D, D, 0);
    ngemm<EpiGate><<<dim3(D / 64, T / 64, 1), 256, 0, stream>>>(R2, nullptr, w_pb, 0, 0, EpiGate{ob, Z, ZGB, 1}, D, D, D, 0);
    ngemm<EpiStore><<<dim3(D / 64, T / 64, 1), 256, 0, stream>>>(ob, nullptr, w_o, 0, 0, EpiStore{R1, D, 0, b_o, 0}, D, D, D, 0);
    k_rowln<<<T / 4, 256, 0, stream>>>(xb, R1, g1, ln1_w, ln1_b, ob, nullptr, nullptr, nullptr, ALPHA, T);
    k_rowln<<<T / 4, 256, 0, stream>>>(ob, nullptr, nullptr, nullptr, nullptr, nullptr, sh2, sc2, R2, 1.f, T);
    k_router<<<T / 4, 256, 0, stream>>>(R2, w_router, b_router, AFF);
    k_topk<<<NE * T / 256, 256, 0, stream>>>(AFF, IDX, GATE);
    float* G1 = Z; float* U1 = Z + (size_t)16 * MiB; float* YE = Z + (size_t)32 * MiB;
    ngemm<EpiStore><<<dim3(D / 64, CAP / 64, NE), 256, 0, stream>>>(R2, IDX, w_gate, 0, (long)D * D, EpiStore{G1, D, 0, nullptr, (long)CAP * D}, D, D, D, CAP);
    ngemm<EpiStore><<<dim3(D / 64, CAP / 64, NE), 256, 0, stream>>>(R2, IDX, w_up, 0, (long)D * D, EpiStore{U1, D, 0, nullptr, (long)CAP * D}, D, D, D, CAP);
    k_hidden<<<NE * CAP * D / 256, 256, 0, stream>>>(G1, U1, (size_t)NE * CAP * D);
    ngemm<EpiStore><<<dim3(D / 64, CAP / 64, NE), 256, 0, stream>>>(G1, nullptr, w_down, (long)CAP * D, (long)D * D, EpiStore{YE, D, 0, nullptr, (long)CAP * D}, D, D, D, 0);
    k_zero<<<T * D / 256, 256, 0, stream>>>(R1, (size_t)T * D);
    k_scatter<<<NE * CAP * D / 256, 256, 0, stream>>>(YE, IDX, GATE, R1);
    k_rowln<<<T / 4, 256, 0, stream>>>(ob, R1, g2, ln2_w, ln2_b, ob, nullptr, nullptr, nullptr, ALPHA, T);
  }
}
```

```cpp
#include <hip/hip_runtime.h>
#include <cstdio>
#include <cstdint>

namespace pg8 {
#define PG8_LAS __attribute__((address_space(3)))
typedef unsigned short bf16_t;
typedef short bf16x8 __attribute__((ext_vector_type(8)));
typedef float f32x4 __attribute__((ext_vector_type(4)));
typedef unsigned u32x4 __attribute__((ext_vector_type(4)));
constexpr int BM = 256, BK = 64, HALF = 128, HTB = HALF * BK * 2  , STAGE_BYTES = 8 * HTB, NXCD = 8, WGM = 8;

__host__ __device__ __forceinline__ int lds_byte(int r, int c) { const int st = (r >> 4) * 2 + (c >> 5), rr = r & 15, cc = c & 31, ob = rr * 64 + cc * 2; return st * 1024 + (ob ^ (((ob >> 9) & 1) << 5)); }
__host__ __device__ __forceinline__ void stage_rc(int b, int& R, int& C) { const int st = b / 1024, sb = b % 1024, swz = sb ^ (((sb >> 9) & 1) << 5); R = (st >> 1) * 16 + swz / 64; C = (st & 1) * 32 + (swz % 64) / 2; }
__host__ __device__ __forceinline__ int perm32(int rho) { const int n = rho >> 4, i = rho & 15; return 8 * (i >> 2) + 4 * n + (i & 3); }

struct Unit { int pm, pn; };
struct Gemm { const bf16_t* A; const bf16_t* Bt; int M, N, K; };

struct StaticOrder {
    int nM, nN, nwg, G, c;
    __host__ __device__ void init(int M, int N, int G_, int c_) { nM = M / BM; nN = N / BM; nwg = nM * nN; G = G_; c = c_; }
    __host__ __device__ bool next(int i, Unit& u) const {
        const long L = (long)i * G + c; if (L >= nwg) return false;
        int wgid = (int)L; { const int q = nwg / NXCD, r = nwg % NXCD, xcd = wgid % NXCD, off = wgid / NXCD; wgid = (xcd < r ? xcd * (q + 1) : r * (q + 1) + (xcd - r) * q) + off; }
        const int nig = WGM * nN, gid = wgid / nig, fm = gid * WGM, gsz = (nM - fm) < WGM ? (nM - fm) : WGM;
        u.pm = fm + ((wgid % nig) % gsz); u.pn = (wgid % nig) / gsz; return true;
    }
    __device__ __forceinline__ void a_ready(const Unit&) const {}
    __device__ __forceinline__ void done(const Unit&) const {}
};

typedef float f32x2c __attribute__((ext_vector_type(2)));
typedef __bf16 bf16x2c __attribute__((ext_vector_type(2)));
__device__ __forceinline__ unsigned cvt_pk_bf16(float lo, float hi) { const f32x2c v = {lo, hi}; return __builtin_bit_cast(unsigned, __builtin_convertvector(v, bf16x2c)); }
__device__ __forceinline__ unsigned cvt_pk2(f32x2c v) { return __builtin_bit_cast(unsigned, __builtin_convertvector(v, bf16x2c)); }

struct XUnit { int pm, pn; const char* A; const char* B; int flags; int pad; };
constexpr size_t TS1K = (size_t)256 * 1024 * 2;
constexpr float KSCALE_F = 0.08838834764831845f;
__device__ __forceinline__ float fsig(float x) { return __builtin_amdgcn_rcpf(1.f + __expf(-x)); }
__device__ __forceinline__ float fsilu(float x) { return x * fsig(x); }
__device__ __forceinline__ float fgelu(float x) { return x * fsig(1.5957691216057308f * x * (1.f + 0.044715f * x * x)); }
__device__ __forceinline__ float fact(float x, int act) { return act == 0 ? x : (act == 1 ? fsilu(x) : (act == 2 ? fgelu(x) : fsig(x))); }

struct EpiZ {
    static constexpr bool PERM = true, AFTER_DRAIN = false;
    bf16_t *Q, *V, *KC, *VC; const float* bias; const float* tab; float* vstat;
    __device__ __forceinline__ void transform(f32x4 (&)[2][2][4][2], const XUnit&, int, int, int, int) const {}
    __device__ __forceinline__ void operator()(const f32x4 (&acc)[2][2][4][2], const XUnit& u, int wr, int wc, int fr, int fq) const {
        const int pn = u.pn; const bool isctx = u.pm >= 64;
        const int rowbase = (isctx ? (u.pm - 64) : u.pm) * 256 + wr * 64 + fr;
        if (pn < 4) {
            const bool isk = pn >= 2; const int tile = pn & 1;
            bf16_t* dst = isctx ? KC : Q + (isk ? (size_t)8 * 1048576 : (size_t)0);
            const float scale = isk ? KSCALE_F : 1.f;
            const int lc = 256 * tile + 64 * wc + 8 * fq;
            const int a = wc & 1;
            const float* bp = bias + (isk ? 512 : 0) + lc;
            f32x4 b1[2], b2[2];
#pragma unroll
            for (int n = 0; n < 2; ++n) { b1[n] = *(const f32x4*)(bp + 4 * n); b2[n] = *(const f32x4*)(bp + 32 + 4 * n); }
            f32x4 tt[4], tn[4];
            { const int t = rowbase & 8191; const int pos = a ? (t & 63) : (t >> 6); const float* tp = tab + (pos * 32 + 8 * fq) * 2;
#pragma unroll
              for (int j = 0; j < 4; ++j) tt[j] = isctx ? (f32x4){1.f, 0.f, 1.f, 0.f} : *(const f32x4*)(tp + 4 * j); }
#pragma unroll
            for (int it = 0; it < 8; ++it) {
                    const int ai = it >> 2, m = it & 3;
                    const int row = rowbase + ai * 128 + m * 16;
                    if (it < 7) { const int rown = rowbase + ((it + 1) >> 2) * 128 + ((it + 1) & 3) * 16; const int t = rown & 8191; const int pos = a ? (t & 63) : (t >> 6); const float* tp = tab + (pos * 32 + 8 * fq) * 2;
#pragma unroll
                        for (int j = 0; j < 4; ++j) tn[j] = isctx ? (f32x4){1.f, 0.f, 1.f, 0.f} : *(const f32x4*)(tp + 4 * j); }
                    float o1[8], o2[8];
#pragma unroll
                    for (int j = 0; j < 8; ++j) { const float x1 = acc[ai][0][m][j >> 2][j & 3] + b1[j >> 2][j & 3], x2 = acc[ai][1][m][j >> 2][j & 3] + b2[j >> 2][j & 3];
                        const float cs = tt[j >> 1][(j & 1) * 2], sn = tt[j >> 1][(j & 1) * 2 + 1];
                        o1[j] = (x1 * cs - x2 * sn) * scale; o2[j] = (x2 * cs + x1 * sn) * scale; }
                    u32x4 w1, w2;
                    w1.x = cvt_pk_bf16(o1[0], o1[1]); w1.y = cvt_pk_bf16(o1[2], o1[3]); w1.z = cvt_pk_bf16(o1[4], o1[5]); w1.w = cvt_pk_bf16(o1[6], o1[7]);
                    w2.x = cvt_pk_bf16(o2[0], o2[1]); w2.y = cvt_pk_bf16(o2[2], o2[3]); w2.z = cvt_pk_bf16(o2[4], o2[5]); w2.w = cvt_pk_bf16(o2[6], o2[7]);
                    { const int head = 2 * tile + (wc >> 1), db1 = (wc & 1) * 8 + fq;
                      const size_t tb = isctx ? ((size_t)(((row >> 8) * 4 + head) * 2 + ((row >> 7) & 1)) * 16) : ((size_t)(((row >> 13) * 4 + head) * 64 + ((row & 8191) >> 7)) * 16);
                      bf16_t* rp = dst + ((tb + db1) * 128 + (row & 127)) * 8;
                      __builtin_nontemporal_store(w1, (u32x4*)rp); __builtin_nontemporal_store(w2, (u32x4*)(rp + 4 * 128 * 8)); }
#pragma unroll
                    for (int j = 0; j < 4; ++j) tt[j] = tn[j];
                }
        } else {
            switch ((pn - 4) >> 2) {
                case 0: sect<0>(acc, pn, isctx, rowbase, wc, fq); break;
                case 1: sect<1>(acc, pn, isctx, rowbase, wc, fq); break;
                case 2: sect<2>(acc, pn, isctx, rowbase, wc, fq); break;
                case 3: sect<3>(acc, pn, isctx, rowbase, wc, fq); break;
                case 4: sect<4>(acc, pn, isctx, rowbase, wc, fq); break;
                default: sect<5>(acc, pn, isctx, rowbase, wc, fq); break;
            }
        }
    }
    template <int ACT> static __device__ __forceinline__ void act8(f32x2c (&o)[4]) {
        if constexpr (ACT != 0) {
            f32x2c e[4];
#pragma unroll
            for (int j = 0; j < 4; ++j) {
                if constexpr (ACT == 2) e[j] = o[j] * __builtin_elementwise_fma(o[j] * o[j], (f32x2c)(-1.442695041f * 1.5957691216057308f * 0.044715f), (f32x2c)(-1.442695041f * 1.5957691216057308f));
                else e[j] = o[j] * -1.442695041f; }
#pragma unroll
            for (int j = 0; j < 4; ++j) { e[j].x = __builtin_amdgcn_exp2f(e[j].x); e[j].y = __builtin_amdgcn_exp2f(e[j].y); }
#pragma unroll
            for (int j = 0; j < 4; ++j) { e[j] = e[j] + 1.f; e[j].x = __builtin_amdgcn_rcpf(e[j].x); e[j].y = __builtin_amdgcn_rcpf(e[j].y); }
#pragma unroll
            for (int j = 0; j < 4; ++j) o[j] = ACT == 3 ? e[j] : o[j] * e[j];
        }
    }
    template <int S> __device__ __forceinline__ void sect(const f32x4 (&acc)[2][2][4][2], int pn, bool isctx, int rowbase, int wc, int fq) const {
            constexpr int ACT = S == 0 ? 0 : (S + 2) >> 1;
            bf16_t* dst = (S == 0 && isctx) ? VC : V + (size_t)S * 16 * 1048576;
            const int col0 = 256 * ((pn - 4) & 3) + 32 * wc + 8 * fq;
            const float* bp = bias + 256 * pn + 32 * wc + 8 * fq;
            f32x4 bv[2][2];
#pragma unroll
            for (int bj = 0; bj < 2; ++bj)
#pragma unroll
                for (int n = 0; n < 2; ++n) bv[bj][n] = *(const f32x4*)(bp + bj * 128 + 4 * n);
#pragma unroll
            for (int ai = 0; ai < 2; ++ai)
#pragma unroll
                for (int m = 0; m < 4; ++m) {
                    const int row = rowbase + ai * 128 + m * 16;
                    bf16_t* rp = dst + (size_t)row * 1024 + col0;
                    size_t gstep = 128;
                    if constexpr (S == 0) { const size_t tb = isctx ? ((size_t)(((row >> 8) * 4 + ((pn - 4) & 3)) * 2 + ((row >> 7) & 1)) * 32) : ((size_t)(((row >> 13) * 4 + ((pn - 4) & 3)) * 64 + ((row & 8191) >> 7)) * 32);
                        rp = dst + ((tb + 4 * wc + fq) * 128 + (row & 127)) * 8; gstep = (size_t)16 * 128 * 8; }
                    if constexpr (S == 3) { const size_t tb = (size_t)((((row >> 13) * 64 + ((row & 8191) >> 7)) * 4 + (pn - 16)) * 32);
                        rp = dst + ((tb + 4 * wc + fq) * 128 + (row & 127)) * 8; gstep = (size_t)16 * 128 * 8; }
                    f32x2c ssum2 = {0.f, 0.f}, ssq2 = {0.f, 0.f};
#pragma unroll
                    for (int bj = 0; bj < 2; ++bj) {
                        f32x2c o[4];
#pragma unroll
                        for (int j = 0; j < 4; ++j) { const f32x4 t = acc[ai][bj][m][j >> 1] + bv[bj][j >> 1]; o[j] = (j & 1) ? (f32x2c){t[2], t[3]} : (f32x2c){t[0], t[1]}; }
                        act8<ACT>(o);
                        if constexpr (S == 3) {
#pragma unroll
                            for (int j = 0; j < 4; ++j) { ssum2 += o[j]; ssq2 = __builtin_elementwise_fma(o[j], o[j], ssq2); } }
                        u32x4 w; w.x = cvt_pk2(o[0]); w.y = cvt_pk2(o[1]); w.z = cvt_pk2(o[2]); w.w = cvt_pk2(o[3]);
                        __builtin_nontemporal_store(w, (u32x4*)(rp + bj * gstep));
                    }
                    if constexpr (S == 3) {
                        float ssum = ssum2.x + ssum2.y, ssq = ssq2.x + ssq2.y;
                        ssum += __shfl_xor(ssum, 16); ssum += __shfl_xor(ssum, 32); ssq += __shfl_xor(ssq, 16); ssq += __shfl_xor(ssq, 32);
                        if (fq == 0) { float* sp = vstat + ((size_t)row * 16 + (pn - 16) * 4 + wc) * 2; sp[0] = ssum; sp[1] = ssq; } }
                }
    }
};
__device__ __forceinline__ void plain_offs(int tid, int K, unsigned (&o0)[2], unsigned (&o1)[2]) {
#pragma unroll
    for (int i = 0; i < 2; ++i) { int R, C; stage_rc(tid * 16 + i * 8192, R, C); o0[i] = (unsigned)(R * K + C) * 2u; o1[i] = o0[i] + (unsigned)(HALF * K * 2); }
}
constexpr int NG2 = 232, CF0 = 168;
struct SchedP2 {
    StaticOrder so; int G, c; const char* A; const char* B; bool front; unsigned* flag;
    __device__ void init(int G_, int c_, const void* A_, const void* B_, unsigned* flag_, bool front_) { so.init(16384, 7168, G_, c_); G = G_; c = c_; A = (const char*)A_; B = (const char*)B_; front = front_; flag = flag_; }
    __device__ bool next(int i, XUnit& u) const {
        Unit t;
        if (front) { const bool cx = c >= CF0 && c < CF0 + 12; if (cx && i == 0) { t.pm = 64 + (c - CF0) / 6; t.pn = 2 + (c - CF0) % 6; } else if (!so.next(cx ? i - 1 : i, t)) return false; }
        else if (!so.next(i, t)) { const long L = (long)i * G + c - 1792; if (L < 0 || L >= 12) return false; t.pm = 64 + (int)(L / 6); t.pn = 2 + (int)(L % 6); }
        u.pm = t.pm; u.pn = t.pn; u.A = A + (size_t)t.pm * TS1K; u.B = B + (size_t)t.pn * TS1K; u.flags = 3; return true;
    }
    __device__ __forceinline__ void a_ready(const XUnit&) const {}
    __device__ __forceinline__ void after_unit(const XUnit& u, int tid) const {
        if (front && u.pm >= 64) {
            asm volatile("s_waitcnt vmcnt(0)" ::: "memory");
            __builtin_amdgcn_s_barrier();
            if (tid == 0) { __builtin_amdgcn_fence(__ATOMIC_RELEASE, "agent"); asm volatile("s_waitcnt vmcnt(0)" ::: "memory"); __hip_atomic_fetch_add(flag, 1u, __ATOMIC_RELAXED, __HIP_MEMORY_SCOPE_AGENT); }
        }
    }
    __device__ __forceinline__ void offs(const XUnit&, int tid, int K, unsigned (&o0)[2], unsigned (&o1)[2]) const { plain_offs(tid, K, o0, o1); }
};
struct SchedN {
    StaticOrder so; const char* A; const char* B;
    __device__ void init(int M_, int N_, int G_, int c_, const void* A_, const void* B_) { so.init(M_, N_, G_, c_); A = (const char*)A_; B = (const char*)B_; }
    __device__ bool next(int i, XUnit& u) const { Unit t; if (!so.next(i, t)) return false; u.pm = t.pm; u.pn = t.pn; u.A = A + (size_t)t.pm * TS1K; u.B = B + (size_t)t.pn * TS1K; u.flags = 3; return true; }
    __device__ __forceinline__ void a_ready(const XUnit&) const {}
    __device__ __forceinline__ void after_unit(const XUnit&, int) const {}
    __device__ __forceinline__ void offs(const XUnit&, int tid, int K, unsigned (&o0)[2], unsigned (&o1)[2]) const { plain_offs(tid, K, o0, o1); }
};
struct SchedY {
    StaticOrder so; const char *A1, *B1, *A2, *B2;
    __device__ void init(int M_, int N_, int G_, int c_, const void* a1, const void* b1, const void* a2, const void* b2) { so.init(M_, N_, G_, c_); A1 = (const char*)a1; B1 = (const char*)b1; A2 = (const char*)a2; B2 = (const char*)b2; }
    __device__ bool next(int i, XUnit& u) const { Unit t; if (!so.next(i >> 1, t)) return false; u.pm = t.pm; u.pn = t.pn;
        if ((i & 1) == 0) { u.A = A1 + (size_t)t.pm * TS1K; u.B = B1 + (size_t)t.pn * TS1K; u.flags = 1 | 4; } else { u.A = A2 + (size_t)t.pm * TS1K; u.B = B2 + (size_t)t.pn * TS1K; u.flags = 2; } return true; }
    __device__ __forceinline__ void a_ready(const XUnit&) const {}
    __device__ __forceinline__ void after_unit(const XUnit&, int) const {}
    __device__ __forceinline__ void offs(const XUnit&, int tid, int K, unsigned (&o0)[2], unsigned (&o1)[2]) const { plain_offs(tid, K, o0, o1); }
};
__device__ __forceinline__ void unpack8(const u32x4& w, float (&f)[8]) {
#pragma unroll
    for (int j = 0; j < 4; ++j) { f[2 * j] = __builtin_bit_cast(float, w[j] << 16); f[2 * j + 1] = __builtin_bit_cast(float, w[j] & 0xffff0000u); }
}
struct EpiY {
    static constexpr bool PERM = true;
    const bf16_t* SGA; const bf16_t* SGB; bf16_t* Y;
    __device__ __forceinline__ void transform(f32x4 (&acc)[2][2][4][2], const XUnit& u, int wr, int wc, int fr, int fq) const {
        const int row0 = u.pm * BM + wr * 64 + fr, col0 = u.pn * BM + wc * 32 + 8 * fq;
        u32x4 ra[3][2], rb[3][2];
#pragma unroll
        for (int it = 0; it < 3; ++it) { const size_t o = (size_t)(row0 + (it >> 2) * HALF + (it & 3) * 16) * 1024 + col0;
            ra[it][0] = *(const u32x4*)(SGA + o); ra[it][1] = *(const u32x4*)(SGA + o + HALF); rb[it][0] = *(const u32x4*)(SGB + o); rb[it][1] = *(const u32x4*)(SGB + o + HALF); }
#pragma unroll
        for (int it = 0; it < 8; ++it) { const int ai = it >> 2, m = it & 3, sl = it % 3;
#pragma unroll
            for (int bj = 0; bj < 2; ++bj) { float a[8], b[8]; unpack8(ra[sl][bj], a); unpack8(rb[sl][bj], b);
#pragma unroll
                for (int j = 0; j < 8; ++j) acc[ai][bj][m][j >> 2][j & 3] *= a[j] * __builtin_amdgcn_rcpf(fmaxf(b[j], 1e-30f)); }
            if (it + 3 < 8) { const size_t o = (size_t)(row0 + ((it + 3) >> 2) * HALF + ((it + 3) & 3) * 16) * 1024 + col0;
                ra[sl][0] = *(const u32x4*)(SGA + o); ra[sl][1] = *(const u32x4*)(SGA + o + HALF); rb[sl][0] = *(const u32x4*)(SGB + o); rb[sl][1] = *(const u32x4*)(SGB + o + HALF); } }
    }
    __device__ __forceinline__ void operator()(const f32x4 (&acc)[2][2][4][2], const XUnit& u, int wr, int wc, int fr, int fq) const {
        const int row0 = u.pm * BM + wr * 64 + fr, col0 = u.pn * BM + wc * 32 + 8 * fq;
        u32x4 rb[4][2];
#pragma unroll
        for (int it = 0; it < 4; ++it) { const size_t o = (size_t)(row0 + (it >> 2) * HALF + (it & 3) * 16) * 1024 + col0; rb[it][0] = *(const u32x4*)(SGB + o); rb[it][1] = *(const u32x4*)(SGB + o + HALF); }
#pragma unroll
        for (int it = 0; it < 8; ++it) { const int ai = it >> 2, m = it & 3, sl = it & 3; const size_t o = (size_t)(row0 + ai * HALF + m * 16) * 1024 + col0;
            u32x4 w[2];
#pragma unroll
            for (int bj = 0; bj < 2; ++bj) { float b[8]; unpack8(rb[sl][bj], b); float y[8];
#pragma unroll
                for (int j = 0; j < 8; ++j) y[j] = acc[ai][bj][m][j >> 2][j & 3] * fmaxf(b[j], 1e-30f);
                w[bj].x = cvt_pk_bf16(y[0], y[1]); w[bj].y = cvt_pk_bf16(y[2], y[3]); w[bj].z = cvt_pk_bf16(y[4], y[5]); w[bj].w = cvt_pk_bf16(y[6], y[7]); }
            if (it + 4 < 8) { const size_t on = (size_t)(row0 + ((it + 4) >> 2) * HALF + ((it + 4) & 3) * 16) * 1024 + col0; rb[sl][0] = *(const u32x4*)(SGB + on); rb[sl][1] = *(const u32x4*)(SGB + on + HALF); }
            *(u32x4*)(Y + o) = w[0]; *(u32x4*)(Y + o + HALF) = w[1]; }
    }
};
struct EpiMix {
    static constexpr bool PERM = false;
    const float* x; const float* mod; const float* bo; float* out;
    __device__ __forceinline__ void transform(f32x4 (&)[2][2][4][2], const XUnit&, int, int, int, int) const {}
    __device__ __forceinline__ void operator()(const f32x4 (&acc)[2][2][4][2], const XUnit& u, int wr, int wc, int fr, int fq) const {
        const int row0 = u.pm * BM + wr * 64 + fr, col0 = u.pn * BM + wc * 32 + 4 * fq;
        const float* g1 = mod + (u.pm >= 32 ? 6144 : 0) + 2048;
        f32x4 bv[2][2], gv[2][2];
#pragma unroll
        for (int bj = 0; bj < 2; ++bj)
#pragma unroll
            for (int n = 0; n < 2; ++n) { bv[bj][n] = *(const f32x4*)(bo + col0 + bj * HALF + n * 16); gv[bj][n] = *(const f32x4*)(g1 + col0 + bj * HALF + n * 16); }
        f32x4 rx[3][2][2];
#pragma unroll
        for (int it = 0; it < 3; ++it) { const size_t o = (size_t)(row0 + (it >> 2) * HALF + (it & 3) * 16) * 1024 + col0;
#pragma unroll
          for (int bj = 0; bj < 2; ++bj)
#pragma unroll
              for (int n = 0; n < 2; ++n) rx[it][bj][n] = *(const f32x4*)(x + o + bj * HALF + n * 16); }
#pragma unroll
        for (int it = 0; it < 8; ++it) { const int ai = it >> 2, m = it & 3, sl = it % 3; const size_t o = (size_t)(row0 + ai * HALF + m * 16) * 1024 + col0;
            f32x4 r[2][2];
#pragma unroll
            for (int bj = 0; bj < 2; ++bj)
#pragma unroll
                for (int n = 0; n < 2; ++n) r[bj][n] = rx[sl][bj][n] * 1.189207115002721f + gv[bj][n] * (acc[ai][bj][m][n] + bv[bj][n]);
            if (it + 3 < 8) { const size_t on = (size_t)(row0 + ((it + 3) >> 2) * HALF + ((it + 3) & 3) * 16) * 1024 + col0;
#pragma unroll
                for (int bj = 0; bj < 2; ++bj)
#pragma unroll
                    for (int n = 0; n < 2; ++n) rx[sl][bj][n] = *(const f32x4*)(x + on + bj * HALF + n * 16); }
#pragma unroll
            for (int bj = 0; bj < 2; ++bj)
#pragma unroll
                for (int n = 0; n < 2; ++n) *(f32x4*)(out + o + bj * HALF + n * 16) = r[bj][n]; }
    }
};

struct SchedG1 {
    int G, c; const char* H2; const char* W; const int* idx;
    __device__ void init(int G_, int c_, const void* h2, const void* w, const int* idx_) { G = G_; c = c_; H2 = (const char*)h2; W = (const char*)w; idx = idx_; }
    __device__ bool next(int i, XUnit& u) const { const long L = (long)i * G + c; if (L >= 1024) return false;
        const int g = (int)(L >> 5), r = (int)(L & 31); u.pm = g * 4 + (r & 3); u.pn = r >> 2;
        u.A = H2 + (size_t)(g >> 4) * 8192 * 2048; u.B = W + ((size_t)(g & 15) * 2048 + (size_t)u.pn * 256) * 2048; u.flags = 3; return true; }
    __device__ __forceinline__ void a_ready(const XUnit&) const {}
    __device__ __forceinline__ void after_unit(const XUnit&, int) const {}
    __device__ __forceinline__ void offs(const XUnit& u, int tid, int K, unsigned (&o0)[2], unsigned (&o1)[2]) const {
#pragma unroll
        for (int i = 0; i < 2; ++i) { int R, C; stage_rc(tid * 16 + i * 8192, R, C);
            const int t0 = idx[u.pm * 256 + R], t1 = idx[u.pm * 256 + 128 + R];
            o0[i] = (unsigned)(t0 * K + C) * 2u; o1[i] = (unsigned)(t1 * K + C) * 2u; }
    }
};
struct EpiH {
    static constexpr bool PERM = true;
    bf16_t* HID;
    __device__ __forceinline__ void transform(f32x4 (&)[2][2][4][2], const XUnit&, int, int, int, int) const {}
    __device__ __forceinline__ void operator()(const f32x4 (&acc)[2][2][4][2], const XUnit& u, int wr, int wc, int fr, int fq) const {
        const int row0 = u.pm * BM + wr * 64 + fr, col0 = u.pn * 128 + wc * 32 + 8 * fq;
#pragma unroll
        for (int ai = 0; ai < 2; ++ai)
#pragma unroll
            for (int m = 0; m < 4; ++m) { float h[8];
#pragma unroll
                for (int j = 0; j < 8; ++j) { const float gt = acc[ai][0][m][j >> 2][j & 3], up = acc[ai][1][m][j >> 2][j & 3]; h[j] = fsilu(gt) * up; }
                u32x4 w; w.x = cvt_pk_bf16(h[0], h[1]); w.y = cvt_pk_bf16(h[2], h[3]); w.z = cvt_pk_bf16(h[4], h[5]); w.w = cvt_pk_bf16(h[6], h[7]);
                *(u32x4*)(HID + (size_t)(row0 + ai * HALF + m * 16) * 1024 + col0) = w; }
    }
};
struct SchedG2 {
    int G, c; const char* HID; const char* W;
    __device__ void init(int G_, int c_, const void* hid, const void* w) { G = G_; c = c_; HID = (const char*)hid; W = (const char*)w; }
    __device__ bool next(int i, XUnit& u) const { const long L = (long)i * G + c; if (L >= 512) return false;
        const int g = (int)(L >> 4), r = (int)(L & 15); u.pm = g * 4 + (r & 3); u.pn = r >> 2;
        u.A = HID + (size_t)u.pm * TS1K; u.B = W + ((size_t)(g & 15) * 1024 + (size_t)u.pn * 256) * 2048; u.flags = 3; return true; }
    __device__ __forceinline__ void a_ready(const XUnit&) const {}
    __device__ __forceinline__ void after_unit(const XUnit&, int) const {}
    __device__ __forceinline__ void offs(const XUnit&, int tid, int K, unsigned (&o0)[2], unsigned (&o1)[2]) const { plain_offs(tid, K, o0, o1); }
};
struct EpiYE {
    static constexpr bool PERM = true;
    bf16_t* YE; const float* gatew;
    __device__ __forceinline__ void transform(f32x4 (&)[2][2][4][2], const XUnit&, int, int, int, int) const {}
    __device__ __forceinline__ void operator()(const f32x4 (&acc)[2][2][4][2], const XUnit& u, int wr, int wc, int fr, int fq) const {
        const int row0 = u.pm * BM + wr * 64 + fr, col0 = u.pn * BM + wc * 32 + 8 * fq;
        float gts[8];
#pragma unroll
        for (int it = 0; it < 8; ++it) gts[it] = gatew[row0 + (it >> 2) * HALF + (it & 3) * 16];
#pragma unroll
        for (int ai = 0; ai < 2; ++ai)
#pragma unroll
            for (int m = 0; m < 4; ++m) { const int row = row0 + ai * HALF + m * 16; const float gt = gts[ai * 4 + m];
#pragma unroll
                for (int bj = 0; bj < 2; ++bj) { float y[8];
#pragma unroll
                    for (int j = 0; j < 8; ++j) y[j] = acc[ai][bj][m][j >> 2][j & 3] * gt;
                    u32x4 w; w.x = cvt_pk_bf16(y[0], y[1]); w.y = cvt_pk_bf16(y[2], y[3]); w.z = cvt_pk_bf16(y[4], y[5]); w.w = cvt_pk_bf16(y[6], y[7]);
                    *(u32x4*)(YE + (size_t)row * 1024 + col0 + bj * HALF) = w; } }
    }
};

template <class Epi, class Sched, bool ALIGN_EPI = false, bool SP2 = false>
__device__ __forceinline__ void gemm_phase(PG8_LAS unsigned char* lds, const int K, const Sched& S, const Epi& E) {
    const int tid = threadIdx.x, wid = __builtin_amdgcn_readfirstlane(tid >> 6), lane = tid & 63, wr = wid >> 2, wc = wid & 3, fr = lane & 15, fq = lane >> 4;
    const int nt = K / BK;
    unsigned voffA[2], voffB[2];
#pragma unroll
    for (int i = 0; i < 2; ++i) { int R, C; stage_rc(tid * 16 + i * 8192, R, C); const int Rb = Epi::PERM ? ((R & ~31) + perm32(R & 31)) : R;
        voffA[i] = (unsigned)(R * K + C) * 2u; voffB[i] = (unsigned)(Rb * K + C) * 2u; }
    unsigned oc0[2], oc1[2], on0[2], on1[2];
    const size_t kstep = (size_t)(BK * 2);
    const size_t hstep = (size_t)HALF * K * 2;
    const size_t tstep = 2 * hstep;
    const unsigned ldsw = (unsigned)wid * 1024u;
    const int aoff = lds_byte(wr * 64 + fr, fq * 8), boff = lds_byte(wc * 32 + fr, fq * 8);
#define PG8_SA(b, h) (((b) * 2 + (h)) * HTB)
#define PG8_SB(b, h) ((4 + (b) * 2 + (h)) * HTB)
#define PG8_STAGE(bufoff, gbase, voff) do { _Pragma("unroll") for (int _i = 0; _i < 2; ++_i) \
        __builtin_amdgcn_global_load_lds((const unsigned*)((const char*)(gbase) + (voff)[_i]), (PG8_LAS unsigned*)(lds + (bufoff) + ldsw + _i * 8192), 16, 0, 0); } while (0)
#define PG8_LDA(dst, b, h) do { _Pragma("unroll") for (int m = 0; m < 4; ++m) _Pragma("unroll") for (int k = 0; k < 2; ++k) dst[m][k] = *(const PG8_LAS bf16x8*)(lds + PG8_SA(b, h) + aoff + m * 2048 + k * 1024); } while (0)
#define PG8_LDB(dst, b, h) do { _Pragma("unroll") for (int n = 0; n < 2; ++n) _Pragma("unroll") for (int k = 0; k < 2; ++k) dst[n][k] = *(const PG8_LAS bf16x8*)(lds + PG8_SB(b, h) + boff + n * 2048 + k * 1024); } while (0)
#define PG8_MMA(ai, bj, At, Bt) do { __builtin_amdgcn_s_setprio(1); _Pragma("unroll") for (int m = 0; m < 4; ++m) _Pragma("unroll") for (int n = 0; n < 2; ++n) _Pragma("unroll") for (int k = 0; k < 2; ++k) \
        acc[ai][bj][m][n] = __builtin_amdgcn_mfma_f32_16x16x32_bf16(Bt[n][k], At[m][k], acc[ai][bj][m][n], 0, 0, 0); __builtin_amdgcn_s_setprio(0); } while (0)
#define PG8_WAIT_V(n) asm volatile("s_waitcnt vmcnt(" #n ")" ::: "memory")
#define PG8_WAIT_L(n) asm volatile("s_waitcnt lgkmcnt(" #n ")" ::: "memory")
#define PG8_BAR __builtin_amdgcn_s_barrier()
#define PG8_SCHED __builtin_amdgcn_sched_barrier(0)
    XUnit cur, nxt; int ui = 0;
    if (!S.next(0, cur)) return;
    f32x4 acc[2][2][4][2];
#pragma unroll
    for (int a = 0; a < 2; ++a)
#pragma unroll
        for (int b = 0; b < 2; ++b)
#pragma unroll
            for (int m = 0; m < 4; ++m)
#pragma unroll
                for (int n = 0; n < 2; ++n) acc[a][b][m][n] = (f32x4){0.f, 0.f, 0.f, 0.f};
    bf16x8 At[4][2], B0[2][2], B1[2][2];
    const char* cA = cur.A; const char* cB = cur.B;
    S.offs(cur, tid, K, oc0, oc1);
    S.a_ready(cur);
    if constexpr (SP2) {
        PG8_STAGE(PG8_SB(0, 0), cB, voffB); PG8_STAGE(PG8_SB(0, 1), cB + hstep, voffB); PG8_STAGE(PG8_SA(0, 0), cA, oc0); PG8_STAGE(PG8_SA(0, 1), cA, oc1);
        if (wr == 1) PG8_BAR;
        PG8_WAIT_V(2); PG8_BAR;
        PG8_STAGE(PG8_SB(1, 0), cB + kstep, voffB); PG8_STAGE(PG8_SA(1, 0), cA + kstep, oc0); PG8_STAGE(PG8_SB(1, 1), cB + hstep + kstep, voffB);
        PG8_WAIT_V(6); PG8_BAR;
    } else {
        PG8_STAGE(PG8_SB(0, 0), cB, voffB); PG8_STAGE(PG8_SA(0, 0), cA, oc0); PG8_STAGE(PG8_SB(0, 1), cB + hstep, voffB); PG8_STAGE(PG8_SA(0, 1), cA, oc1);
        if (wr == 1) PG8_BAR;
        PG8_WAIT_V(4); PG8_BAR;
        PG8_STAGE(PG8_SB(1, 0), cB + kstep, voffB); PG8_STAGE(PG8_SA(1, 0), cA + kstep, oc0); PG8_STAGE(PG8_SB(1, 1), cB + hstep + kstep, voffB);
        PG8_WAIT_V(6); PG8_BAR;
    }
    for (;;) {
        const bool has_next = S.next(ui + 1, nxt);
        const char* nA = has_next ? nxt.A : cA; const char* nB = has_next ? nxt.B : cB;
        if (has_next) S.offs(nxt, tid, K, on0, on1); else { on0[0] = oc0[0]; on0[1] = oc0[1]; on1[0] = oc1[0]; on1[1] = oc1[1]; }
        for (int t = 0; t < nt; t += 2) {
            const bool last = (t == nt - 2);
            const char* a1 = cA + (size_t)(t + 1) * kstep;
            const char* a2 = last ? nA : cA + (size_t)(t + 2) * kstep; const char* b2 = last ? nB : cB + (size_t)(t + 2) * kstep;
            const char* a3 = a2 + kstep; const char* b3 = b2 + kstep;
            unsigned s0[2], s1[2]; s0[0] = last ? on0[0] : oc0[0]; s0[1] = last ? on0[1] : oc0[1]; s1[0] = last ? on1[0] : oc1[0]; s1[1] = last ? on1[1] : oc1[1];
            if (last && has_next) S.a_ready(nxt);
            if constexpr (SP2) {
            PG8_LDB(B0, 0, 0); PG8_LDB(B1, 0, 1); PG8_SCHED; PG8_LDA(At, 0, 0); PG8_STAGE(PG8_SA(1, 1), a1, oc1);
            PG8_WAIT_V(8); PG8_WAIT_L(0); PG8_BAR; PG8_MMA(0, 0, At, B0); PG8_MMA(0, 1, At, B1); PG8_BAR; PG8_SCHED;
            PG8_LDA(At, 0, 1); PG8_STAGE(PG8_SB(0, 0), b2, voffB); PG8_STAGE(PG8_SB(0, 1), b2 + hstep, voffB); PG8_STAGE(PG8_SA(0, 0), a2, s0);
            PG8_WAIT_V(8); PG8_WAIT_L(0); PG8_BAR; PG8_MMA(1, 0, At, B0); PG8_MMA(1, 1, At, B1); PG8_BAR; PG8_SCHED;
            PG8_LDB(B0, 1, 0); PG8_LDB(B1, 1, 1); PG8_SCHED; PG8_LDA(At, 1, 0); PG8_STAGE(PG8_SA(0, 1), a2, s1);
            PG8_WAIT_V(8); PG8_WAIT_L(0); PG8_BAR; PG8_MMA(0, 0, At, B0); PG8_MMA(0, 1, At, B1); PG8_BAR; PG8_SCHED;
            PG8_LDA(At, 1, 1); PG8_STAGE(PG8_SB(1, 0), b3, voffB); PG8_STAGE(PG8_SB(1, 1), b3 + hstep, voffB); PG8_STAGE(PG8_SA(1, 0), a3, s0);
            PG8_WAIT_V(8); PG8_WAIT_L(0); PG8_BAR; PG8_MMA(1, 0, At, B0); PG8_MMA(1, 1, At, B1); PG8_BAR; PG8_SCHED;
            } else {
            PG8_LDB(B0, 0, 0); PG8_SCHED; PG8_LDA(At, 0, 0); PG8_STAGE(PG8_SA(1, 1), a1, oc1);
            PG8_WAIT_L(8); PG8_BAR; PG8_WAIT_L(0); PG8_MMA(0, 0, At, B0); PG8_BAR; PG8_SCHED;
            PG8_LDB(B1, 0, 1); PG8_STAGE(PG8_SB(0, 0), b2, voffB);
            PG8_BAR; PG8_WAIT_L(0); PG8_MMA(0, 1, At, B1); PG8_BAR;
            PG8_LDA(At, 0, 1); PG8_STAGE(PG8_SA(0, 0), a2, s0);
            PG8_BAR; PG8_WAIT_L(0); PG8_MMA(1, 0, At, B0); PG8_BAR; PG8_SCHED;
            PG8_STAGE(PG8_SB(0, 1), b2 + hstep, voffB);
            PG8_WAIT_V(6); PG8_BAR; PG8_MMA(1, 1, At, B1); PG8_BAR;
            PG8_LDB(B0, 1, 0); PG8_SCHED; PG8_LDA(At, 1, 0); PG8_STAGE(PG8_SA(0, 1), a2, s1);
            PG8_WAIT_L(8); PG8_BAR; PG8_WAIT_L(0); PG8_MMA(0, 0, At, B0); PG8_BAR; PG8_SCHED;
            PG8_LDB(B1, 1, 1); PG8_STAGE(PG8_SB(1, 0), b3, voffB);
            PG8_BAR; PG8_WAIT_L(0); PG8_MMA(0, 1, At, B1); PG8_BAR;
            PG8_LDA(At, 1, 1); PG8_STAGE(PG8_SA(1, 0), a3, s0);
            PG8_BAR; PG8_WAIT_L(0); PG8_MMA(1, 0, At, B0); PG8_BAR; PG8_SCHED;
            PG8_STAGE(PG8_SB(1, 1), b3 + hstep, voffB);
            PG8_WAIT_V(6); PG8_BAR; PG8_MMA(1, 1, At, B1); PG8_BAR;
            }
        }
        if constexpr (ALIGN_EPI) { if (wr == 0) PG8_BAR; }
        if (cur.flags & 4) E.transform(acc, cur, wr, wc, fr, fq);
        if (cur.flags & 2) E(acc, cur, wr, wc, fr, fq);
        S.after_unit(cur, tid);
        if (!has_next) break;
        if (nxt.flags & 1) {
#pragma unroll
        for (int a = 0; a < 2; ++a)
#pragma unroll
            for (int b = 0; b < 2; ++b)
#pragma unroll
                for (int m = 0; m < 4; ++m)
#pragma unroll
                    for (int n = 0; n < 2; ++n) acc[a][b][m][n] = (f32x4){0.f, 0.f, 0.f, 0.f};
        }
        cur = nxt; cA = nA; cB = nB; ++ui; oc0[0] = on0[0]; oc0[1] = on0[1]; oc1[0] = on1[0]; oc1[1] = on1[1];
        if constexpr (ALIGN_EPI) { if (wr == 1) PG8_BAR; }
    }
    PG8_WAIT_V(0);
    if constexpr (!ALIGN_EPI) { if (wr == 0) PG8_BAR; }
    PG8_BAR;
#undef PG8_SA
#undef PG8_SB
#undef PG8_STAGE
#undef PG8_LDA
#undef PG8_LDB
#undef PG8_MMA
#undef PG8_WAIT_V
#undef PG8_WAIT_L
#undef PG8_BAR
#undef PG8_SCHED
}
}

#define GAS __attribute__((address_space(1)))
#define LAS __attribute__((address_space(3)))
constexpr size_t MiB = 1u << 20;

typedef unsigned short bf16;
typedef unsigned v4u __attribute__((ext_vector_type(4)));
typedef float f32x4 __attribute__((ext_vector_type(4)));
typedef short bf16x8 __attribute__((ext_vector_type(8)));
typedef GAS unsigned gu32;
typedef GAS unsigned long long gu64;
#define RLX_AGENT __ATOMIC_RELAXED, __HIP_MEMORY_SCOPE_AGENT
#define LDS_WAIT() asm volatile("s_waitcnt lgkmcnt(0)" ::: "memory")
#define VM_WAIT() asm volatile("s_waitcnt vmcnt(0)" ::: "memory")
__device__ __forceinline__ unsigned long long rt() { return __builtin_amdgcn_s_memrealtime(); }
__device__ __forceinline__ unsigned f2bf(float f) { unsigned u = __builtin_bit_cast(unsigned, f); return (u + 0x7fffu + ((u >> 16) & 1u)) >> 16; }
__device__ __forceinline__ unsigned pk2(float lo, float hi) { return pg8::cvt_pk_bf16(lo, hi); }

#define XB_TMO      128
#define XB_XCNT(j)  (256  + 64 * (j))
#define XB_XSUB(j)  (1280 + 64 * (j))
#define XB_XGEN(j)  (2304 + 64 * (j))
#define XB_TOP      3328
#define XB_TOPGEN   3392
#define XCD_BAR_WORDS 3456
#define XB_SPIN_CAP (1u << 18)

__device__ __forceinline__ unsigned xb_ld(unsigned* p)              { return __hip_atomic_load(p, __ATOMIC_RELAXED, __HIP_MEMORY_SCOPE_AGENT); }
__device__ __forceinline__ unsigned xb_add(unsigned* p, unsigned v) { return __hip_atomic_fetch_add(p, v, __ATOMIC_RELAXED, __HIP_MEMORY_SCOPE_AGENT); }
__device__ __forceinline__ unsigned xb_xcc_id() { return (unsigned)__builtin_amdgcn_s_getreg((3 << 11) | 20) & 0xFu; }
#define XB_SPIN(cond, bar) do { unsigned _sp = 0; while (cond) { __builtin_amdgcn_s_sleep(1); \
    if ((++_sp & 255u) == 0u) { if (xb_ld(&(bar)[XB_TMO])) break; if (_sp > XB_SPIN_CAP) { atomicAdd(&(bar)[XB_TMO], 1u); break; } } } } while (0)

struct XcdBarrier {
    unsigned* bar; unsigned x;
    volatile LAS unsigned* st;
};

__device__ __forceinline__ XcdBarrier xcd_barrier_post(unsigned* bar, volatile LAS unsigned* st) {
    XcdBarrier b; b.bar = bar; b.x = xb_xcc_id(); b.st = st;
    if (threadIdx.x == 0) (void)xb_add(&bar[XB_XCNT(b.x)], 1u);
    return b;
}
__device__ __forceinline__ void xcd_barrier_complete(unsigned* bar, unsigned x, unsigned& nloc, unsigned& nx) {
    const unsigned G = gridDim.x * gridDim.y * gridDim.z;
    unsigned sum, cnt, mine, sp = 0u;
    for (;;) {
        sum = 0u; cnt = 0u; mine = 0u;
#pragma unroll
        for (unsigned j = 0; j < 16; ++j) { const unsigned c = xb_ld(&bar[XB_XCNT(j)]); sum += c; cnt += (c > 0u) ? 1u : 0u; mine = (j == x) ? c : mine; }
        if (sum == G) break;
        __builtin_amdgcn_s_sleep(1);
        if ((++sp & 255u) == 0u) { if (xb_ld(&bar[XB_TMO])) break; if (sp > XB_SPIN_CAP) { atomicAdd(&bar[XB_TMO], 1u); break; } }
    }
    nloc = mine > 0u ? mine : 1u; nx = cnt > 0u ? cnt : 1u;
}

__device__ __forceinline__ void xcd_barrier(const XcdBarrier& b) {
    asm volatile("s_waitcnt vmcnt(0)" ::: "memory");
    __syncthreads();
    if (threadIdx.x == 0) {
        unsigned* bar = b.bar;
        __builtin_amdgcn_s_waitcnt(0);
        unsigned nloc = b.st[0], nx = b.st[1];
        if (nloc == 0u) { xcd_barrier_complete(bar, b.x, nloc, nx); b.st[0] = nloc; b.st[1] = nx; }
        const unsigned old = xb_add(&bar[XB_XSUB(b.x)], 1u);
        const unsigned gen = old / nloc;
        if (old + 1u == (gen + 1u) * nloc) {
            __builtin_amdgcn_fence(__ATOMIC_RELEASE, "agent");
            asm volatile("s_waitcnt vmcnt(0)" ::: "memory");
            const unsigned og = xb_add(&bar[XB_TOP], 1u);
            const unsigned tg = og / nx;
            if (og + 1u == (tg + 1u) * nx) xb_add(&bar[XB_TOPGEN], 1u);
            else XB_SPIN(xb_ld(&bar[XB_TOPGEN]) == tg, bar);
            __builtin_amdgcn_fence(__ATOMIC_ACQUIRE, "agent");
            xb_add(&bar[XB_XGEN(b.x)], 1u);
            asm volatile("s_waitcnt vmcnt(0)" ::: "memory");
        } else {
            XB_SPIN(xb_ld(&bar[XB_TOPGEN]) == gen, bar);
            __builtin_amdgcn_fence(__ATOMIC_ACQUIRE, "agent");
            asm volatile("s_waitcnt vmcnt(0)" ::: "memory");
        }
    }
    __syncthreads();
}

constexpr int D = 1024, NB = 2, T = 8192, M = NB * T, CTXL = 256, MC = NB * CTXL, DIN = 7168, NE = 16, CAP = 1024;
constexpr float LN_EPS = 1e-6f, ALPHA = 1.189207115002721f;
constexpr size_t WS_CTL = 0, CTL_ZERO_BYTES = 1 * MiB;
constexpr int CW_TMO = 0, CW_BAR = 4096;
constexpr size_t WS_MOD = 512 * 1024;
constexpr size_t WS_TAB = 1 * MiB;
constexpr size_t WS_LN1S = 1 * MiB + 256 * 1024;
constexpr size_t WS_VSTAT = 9 * MiB;
constexpr size_t WS_KC = 2 * MiB, WS_VC = 3 * MiB;
constexpr size_t WS_WPA = 12 * MiB, WS_WPB = 14 * MiB, WS_WO = 16 * MiB;
constexpr size_t WS_WIN = 18 * MiB;
constexpr size_t WS_H = 32 * MiB;
constexpr size_t WS_Q = 66 * MiB, WS_K = 82 * MiB, WS_V = 98 * MiB, WS_SG = 130 * MiB, WS_GU = 162 * MiB, WS_GVS = 194 * MiB, WS_SGA = 226 * MiB, WS_SGB = 258 * MiB;
constexpr size_t WS_END = 322 * MiB;
constexpr int RING_OFF = 0, RING_BYTES = 131072, LDSCTL_OFF = RING_BYTES, MISC_OFF = LDSCTL_OFF + 320, LDS_BYTES = 147456;
constexpr int NWAVES = 8;

#define WSU_DPP(v, ctrl, rmask, bc) ((unsigned)__builtin_amdgcn_update_dpp(0, (int)(v), (ctrl), (rmask), 0xF, (bc)))
__device__ __forceinline__ unsigned wave_sum_u(unsigned v) {
    v += WSU_DPP(v, 0xB1, 0xF, true); v += WSU_DPP(v, 0x4E, 0xF, true); v += WSU_DPP(v, 0x141, 0xF, true); v += WSU_DPP(v, 0x140, 0xF, true);
    v += WSU_DPP(v, 0x142, 0xA, false); v += WSU_DPP(v, 0x143, 0xC, false);
    return (unsigned)__builtin_amdgcn_readlane((int)v, 63);
}
#define WS_DPP(v, ctrl, rmask, bc) __builtin_bit_cast(float, __builtin_amdgcn_update_dpp(0, __builtin_bit_cast(int, (v)), (ctrl), (rmask), 0xF, (bc)))
__device__ __forceinline__ float wave_sum(float v) {
    v += WS_DPP(v, 0xB1, 0xF, true);
    v += WS_DPP(v, 0x4E, 0xF, true);
    v += WS_DPP(v, 0x141, 0xF, true);
    v += WS_DPP(v, 0x140, 0xF, true);
    v += WS_DPP(v, 0x142, 0xA, false);
    v += WS_DPP(v, 0x143, 0xC, false);
    return __builtin_bit_cast(float, __builtin_amdgcn_readlane(__builtin_bit_cast(int, v), 63));
}
__device__ __forceinline__ float bf2f(bf16 b) { return __builtin_bit_cast(float, (unsigned)b << 16); }

__device__ __forceinline__ void p0_tr_load(f32x4 (&wv)[8], const float* W, int N, int k0, int n0, int lane) {
#pragma unroll
    for (int i = 0; i < 8; ++i) wv[i] = __builtin_nontemporal_load((const GAS f32x4*)(W + (size_t)(k0 + 8 * i + (lane >> 3)) * N + n0 + (lane & 7) * 4));
}
template <bool NTS = false>
__device__ __forceinline__ void p0_tr_finish(const f32x4 (&wv)[8], int K, bf16* WT, int k0, int dst_n0, LAS float* scr, int lane) {
#pragma unroll
    for (int i = 0; i < 8; ++i) { LAS float* d = scr + (8 * i + (lane >> 3)) * 33 + (lane & 7) * 4; d[0] = wv[i][0]; d[1] = wv[i][1]; d[2] = wv[i][2]; d[3] = wv[i][3]; }
    LDS_WAIT(); asm volatile("" ::: "memory");
    const int c = lane & 7;
#pragma unroll
    for (int j = 0; j < 4; ++j) { const int n = (lane >> 3) + 8 * j; const LAS float* s = scr + (8 * c) * 33 + n;
        v4u o; o.x = pk2(s[0 * 33], s[1 * 33]); o.y = pk2(s[2 * 33], s[3 * 33]); o.z = pk2(s[4 * 33], s[5 * 33]); o.w = pk2(s[6 * 33], s[7 * 33]);
        if (NTS) __builtin_nontemporal_store(o, (GAS v4u*)(WT + (size_t)(dst_n0 + n) * K + k0 + 8 * c)); else *(GAS v4u*)(WT + (size_t)(dst_n0 + n) * K + k0 + 8 * c) = o; }
    LDS_WAIT(); asm volatile("" ::: "memory");
}
template <bool NTS = false>
__device__ __forceinline__ void p0_transpose_item(const float* W, int K, int N, bf16* WT, int k0, int n0, int dst_n0, LAS float* scr, int lane) {
    f32x4 wv[8]; p0_tr_load(wv, W, N, k0, n0, lane); p0_tr_finish<NTS>(wv, K, WT, k0, dst_n0, scr, lane);
}
__device__ __forceinline__ int win_dst_row(int n0) { if (n0 >= 1024) return n0; const int l0 = n0 & 255; return (n0 & ~255) + 128 * ((l0 >> 5) & 1) + 32 * (l0 >> 6); }

struct Args { const float* in[29]; float* out; unsigned char* ws; int ph_lo, ph_hi, li, pad; };

__device__ __forceinline__ void p0_prologue(const Args& A, LAS unsigned char* lds, int gw, int NGW, int wave, int lane, int tid) {
    unsigned char* ws = A.ws;
    LAS float* scr = (LAS float*)(lds + RING_OFF + wave * 16384);
    const float* c = A.in[1]; const float* cctx = A.in[3]; const float* w_ada = A.in[4]; const float* b_ada = A.in[5];
    float* MOD = (float*)(ws + WS_MOD);
    if (gw - wave < 96 * 8) {
        for (int i = tid; i < 3072; i += NWAVES * 64) { const int rr = i >> 10, kk = i & 1023; const float x = rr == 0 ? c[kk] : rr == 1 ? c[1024 + kk] : cctx[kk];
            ((LAS float*)(lds + rr * 16384 + 12288))[kk] = x / (1.f + expf(-x)); } }
    __syncthreads();
    constexpr int T_GEMV = 96 * 8, I_IN = 16 * 224, I_P = 16 * 32, T_TAB = 64, NTR = I_IN + 3 * I_P;
#define P0_ITEM(J, Wp, Np, WTp, k0v, n0v, dnv) const int _j = (J); const bool _in = _j < I_IN; const int _q = _in ? _j : (_j - I_IN) % I_P, _w = _in ? 0 : (_j - I_IN) / I_P; \
        const float* Wp = _in ? A.in[6] : (_w == 0 ? A.in[16] : _w == 1 ? A.in[17] : A.in[18]); const int Np = _in ? DIN : D; \
        bf16* WTp = (bf16*)(ws + (_in ? WS_WIN : (_w == 0 ? WS_WPA : _w == 1 ? WS_WPB : WS_WO))); \
        const int k0v = 64 * (_in ? _q / 224 : _q / 32), n0v = 32 * (_in ? _q % 224 : _q % 32); const int dnv = _in ? win_dst_row(n0v) : n0v
    const bool gemv = gw < T_GEMV && NGW > T_GEMV + 64;
    const int jst = gemv ? NTR : (NGW > T_GEMV + 64 ? NGW - T_GEMV : NGW);
    int j = gemv ? gw : (NGW > T_GEMV + 64 ? T_GEMV + (gw - T_GEMV) : gw);
    if (NGW <= T_GEMV + 64) j = gw;
    { f32x4 wv[8], wn[8];
      if (j < NTR) { P0_ITEM(j, W_, N_, WT_, k0_, n0_, dn_); (void)WT_; (void)dn_; p0_tr_load(wv, W_, N_, k0_, n0_, lane); }
      for (; j < NTR; j += jst) { const int jn = j + jst;
          if (jn < NTR) { P0_ITEM(jn, Wn_, Nn_, WTn_, k0n_, n0n_, dnn_); (void)WTn_; (void)dnn_; p0_tr_load(wn, Wn_, Nn_, k0n_, n0n_, lane); }
          { P0_ITEM(j, W_, N_, WT_, k0_, n0_, dn_); (void)W_; (void)N_; (void)n0_; p0_tr_finish<false>(wv, D, WT_, k0_, dn_, scr, lane); }
#pragma unroll
          for (int i = 0; i < 8; ++i) wv[i] = wn[i]; } }
#undef P0_ITEM
    for (int r = gw; r < T_GEMV + T_TAB; r += NGW) {
        if (r < T_GEMV) {
            const int cc = r % 96, ks = r / 96; const int n = cc * 64 + lane; float a0 = 0.f, a1 = 0.f, a2 = 0.f;
            const LAS float* s0 = (const LAS float*)(lds + 0 * 16384 + 12288), * s1 = (const LAS float*)(lds + 1 * 16384 + 12288), * s2 = (const LAS float*)(lds + 2 * 16384 + 12288);
            const float* wp = w_ada + (size_t)(ks * 128) * 6144 + n;
#pragma unroll 16
            for (int k = 0; k < 128; ++k) { const float w = wp[(size_t)k * 6144]; a0 += s0[ks * 128 + k] * w; a1 += s1[ks * 128 + k] * w; a2 += s2[ks * 128 + k] * w; }
            if (ks == 0) { const float bb = b_ada[n]; a0 += bb; a1 += bb; a2 += bb; }
            atomicAdd(MOD + n, a0); atomicAdd(MOD + 6144 + n, a1); atomicAdd(MOD + 2 * 6144 + n, a2);
            continue; }
        { const int e = (r - T_GEMV) * 64 + lane; const int pos = e >> 5, f = e & 31; const float inv = powf(10000.f, -(float)f / 32.f); const float ang = (float)pos * inv;
          float* tab = (float*)(ws + WS_TAB); tab[2 * e] = cosf(ang); tab[2 * e + 1] = sinf(ang); }
    }
}
template <int NR>
__device__ __forceinline__ void p1_rows(const float* const (&xrow)[NR], bf16* const (&orow)[NR], const float* sh, const float* sc, int lane) {
    f32x4 v[NR][4], a[4], b[4];
#pragma unroll
    for (int r = 0; r < NR; ++r)
#pragma unroll
        for (int j = 0; j < 4; ++j) v[r][j] = __builtin_nontemporal_load((const GAS f32x4*)xrow[r] + lane + 64 * j);
#pragma unroll
    for (int j = 0; j < 4; ++j) { a[j] = *((const GAS f32x4*)sc + lane + 64 * j); b[j] = *((const GAS f32x4*)sh + lane + 64 * j); }
#pragma unroll
    for (int r = 0; r < NR; ++r) {
        float s = 0.f;
#pragma unroll
        for (int j = 0; j < 4; ++j) s += (v[r][j].x + v[r][j].y) + (v[r][j].z + v[r][j].w);
        const float mean = wave_sum(s) * (1.f / D); float s2 = 0.f;
#pragma unroll
        for (int j = 0; j < 4; ++j) { v[r][j] = v[r][j] - mean; s2 += (v[r][j].x * v[r][j].x + v[r][j].y * v[r][j].y) + (v[r][j].z * v[r][j].z + v[r][j].w * v[r][j].w); }
        const float rstd = 1.f / sqrtf(wave_sum(s2) * (1.f / D) + LN_EPS);
        GAS unsigned long long* o8 = (GAS unsigned long long*)orow[r] + lane;
#pragma unroll
        for (int j = 0; j < 4; ++j) { const f32x4 y = v[r][j] * rstd * (a[j] + 1.f) + b[j];
            o8[64 * j] = (unsigned long long)pk2(y.x, y.y) | ((unsigned long long)pk2(y.z, y.w) << 32); }
    }
}

constexpr int TBL_OFF = 132096, LNP_OFF = 133632;
constexpr size_t WS_STCF = 4 * MiB, WS_STCB = 5 * MiB;
constexpr size_t WS_STF = 290 * MiB, WS_STB = 18 * MiB;
__device__ __forceinline__ int img_off(int row, int chunk) { return row * 256 + ((chunk ^ (row & 15)) << 4); }
__device__ __forceinline__ unsigned bfe16(const v4u& v, int j) { return (v[j >> 1] >> (16 * (j & 1))) & 0xffffu; }
template <int MT, int NT>
__device__ __forceinline__ void mm_lds(f32x4 (&acc)[MT][NT], const LAS unsigned char* Aimg, int arow0, const LAS unsigned char* Bimg, int brow0, int fr, int fq) {
#pragma unroll
    for (int s = 0; s < 4; ++s) {
        bf16x8 a[MT], b[NT];
#pragma unroll
        for (int mt = 0; mt < MT; ++mt) a[mt] = *(const LAS bf16x8*)(Aimg + img_off(arow0 + mt * 16 + fr, 4 * s + fq));
#pragma unroll
        for (int nt = 0; nt < NT; ++nt) b[nt] = *(const LAS bf16x8*)(Bimg + img_off(brow0 + 32 * (nt >> 1) + 8 * (fr >> 2) + 4 * (nt & 1) + (fr & 3), 4 * s + fq));
#pragma unroll
        for (int mt = 0; mt < MT; ++mt)
#pragma unroll
            for (int nt = 0; nt < NT; ++nt) acc[mt][nt] = __builtin_amdgcn_mfma_f32_16x16x32_bf16(b[nt], a[mt], acc[mt][nt], 0, 0, 0);
        __builtin_amdgcn_sched_barrier(0);
    }
}
template <int MT, int NT>
__device__ __forceinline__ void mm_gB(f32x4 (&acc)[MT][NT], const LAS unsigned char* Aimg, int arow0, const bf16* Bt, int brow0, int fr, int fq) {
#pragma unroll
    for (int s = 0; s < 4; ++s) {
        bf16x8 a[MT], b[NT];
#pragma unroll
        for (int nt = 0; nt < NT; ++nt) b[nt] = *(const GAS bf16x8*)(Bt + (size_t)(brow0 + nt * 16 + fr) * 128 + 8 * (4 * s + fq));
#pragma unroll
        for (int mt = 0; mt < MT; ++mt) a[mt] = *(const LAS bf16x8*)(Aimg + img_off(arow0 + mt * 16 + fr, 4 * s + fq));
#pragma unroll
        for (int mt = 0; mt < MT; ++mt)
#pragma unroll
            for (int nt = 0; nt < NT; ++nt) acc[mt][nt] = __builtin_amdgcn_mfma_f32_16x16x32_bf16(b[nt], a[mt], acc[mt][nt], 0, 0, 0);
        __builtin_amdgcn_sched_barrier(0);
    }
}
template <int MT, int NT> __device__ __forceinline__ void zero_acc(f32x4 (&acc)[MT][NT]) {
#pragma unroll
    for (int a = 0; a < MT; ++a)
#pragma unroll
        for (int b = 0; b < NT; ++b) acc[a][b] = (f32x4){0.f, 0.f, 0.f, 0.f};
}
template <int NBLK, bool NT = false>
__device__ __forceinline__ void stage_T_load(v4u (&v0)[NBLK / 8], v4u (&v1)[NBLK / 8], const bf16* src, int wave, int lane) {
#pragma unroll
    for (int i = 0; i < NBLK / 8; ++i) { const int db = wave * (NBLK / 8) + i;
        const GAS v4u* p = (const GAS v4u*)(src + ((size_t)db * 128 + 2 * lane) * 8);
        if (NT) { v0[i] = __builtin_nontemporal_load(p); v1[i] = __builtin_nontemporal_load(p + 1); } else { v0[i] = p[0]; v1[i] = p[1]; } }
}
template <int NBLK>
__device__ __forceinline__ void stage_T_write(LAS unsigned char* img, const v4u (&v0)[NBLK / 8], const v4u (&v1)[NBLK / 8], int wave, int lane) {
    const int tp = lane;
#pragma unroll
    for (int i = 0; i < NBLK / 8; ++i) { const int db = wave * (NBLK / 8) + i;
#pragma unroll
        for (int j = 0; j < 8; ++j) { const int row = 8 * db + j; const unsigned w = bfe16(v0[i], j) | (bfe16(v1[i], j) << 16);
            *(LAS unsigned*)(img + row * 256 + (((tp >> 2) ^ (row & 15)) << 4) + (tp & 3) * 4) = w; } }
}
__device__ __forceinline__ void rows128_load(v4u (&v)[4], const bf16* src, int tid) {
#pragma unroll
    for (int i = 0; i < 4; ++i) v[i] = __builtin_nontemporal_load((const GAS v4u*)(src + (size_t)(tid + 512 * i) * 8));
}
__device__ __forceinline__ void rows128_write(LAS unsigned char* img, const v4u (&v)[4], int tid) {
#pragma unroll
    for (int i = 0; i < 4; ++i) { const int idx = tid + 512 * i, ch = idx >> 7, r = idx & 127; *(LAS v4u*)(img + img_off(r, ch)) = v[i]; }
}
__device__ __forceinline__ void rows256_load(v4u (&v)[8], const bf16* src, int tid) {
#pragma unroll
    for (int i = 0; i < 8; ++i) v[i] = __builtin_nontemporal_load((const GAS v4u*)(src + (size_t)(tid + 512 * i) * 8));
}
__device__ __forceinline__ void rows256_write(LAS unsigned char* img, const v4u (&v)[8], int tid) {
#pragma unroll
    for (int i = 0; i < 8; ++i) { const int idx = tid + 512 * i, r = idx >> 4, ch = idx & 15; *(LAS v4u*)(img + img_off(r, ch)) = v[i]; }
}
__device__ __forceinline__ v4u pack8(const f32x4& a, const f32x4& b) { v4u o; o.x = pk2(a[0], a[1]); o.y = pk2(a[2], a[3]); o.z = pk2(b[0], b[1]); o.w = pk2(b[2], b[3]); return o; }
__device__ __forceinline__ void unpack8f(const v4u& w, f32x4& a, f32x4& b) { a[0] = bf2f((bf16)(w.x & 0xffff)); a[1] = bf2f((bf16)(w.x >> 16)); a[2] = bf2f((bf16)(w.y & 0xffff)); a[3] = bf2f((bf16)(w.y >> 16)); b[0] = bf2f((bf16)(w.z & 0xffff)); b[1] = bf2f((bf16)(w.z >> 16)); b[2] = bf2f((bf16)(w.w & 0xffff)); b[3] = bf2f((bf16)(w.w >> 16)); }
__device__ __forceinline__ unsigned long long pack4(const f32x4& v) { return (unsigned long long)pk2(v[0], v[1]) | ((unsigned long long)pk2(v[2], v[3]) << 32); }

__device__ __forceinline__ void p3a_kv_fill(LAS unsigned char* lds, const v4u (&a0)[4], const v4u (&a1)[4], const v4u (&k0)[2], const v4u (&k1)[2], float lgf, float lgb, int wave, int lane) {
    LAS unsigned char* VT = lds; LAS unsigned char* KTF = lds + 65536; LAS unsigned char* KTB = lds + 98304;
    asm volatile("" : "+v"(lane));
    const int tp = lane; const float wf0 = expf((float)(127 - 2 * tp) * lgf), wf1 = expf((float)(126 - 2 * tp) * lgf), wb0 = expf((float)(2 * tp) * lgb), wb1 = expf((float)(2 * tp + 1) * lgb);
    stage_T_write<32>(VT, a0, a1, wave, lane);
#pragma unroll
    for (int i = 0; i < 2; ++i) { const int db = wave * 2 + i;
#pragma unroll
        for (int j = 0; j < 8; ++j) { const int row = 8 * db + j; const float a = bf2f((bf16)bfe16(k0[i], j)), c = bf2f((bf16)bfe16(k1[i], j));
            const int off = row * 256 + (((tp >> 2) ^ (row & 15)) << 4) + (tp & 3) * 4;
            *(LAS unsigned*)(KTF + off) = pk2(a * wf0, c * wf1); *(LAS unsigned*)(KTB + off) = pk2(a * wb0, c * wb1); } }
    __syncthreads();
}
__device__ __forceinline__ void p3a_kv_finish(LAS unsigned char* lds, bf16* stf, bf16* stb, int wave, int lane) {
    LAS unsigned char* VT = lds; LAS unsigned char* KTF = lds + 65536; LAS unsigned char* KTB = lds + 98304;
    const int wr = wave >> 2, wc = wave & 3; int fr = lane & 15, fq = lane >> 4; asm volatile("" : "+v"(fr), "+v"(fq));
#pragma unroll
    for (int dir = 0; dir < 2; ++dir) {
        f32x4 acc[8][2]; zero_acc<8, 2>(acc);
        mm_lds<8, 2>(acc, VT, wr * 128, dir == 0 ? KTF : KTB, wc * 32, fr, fq);
        bf16* st = dir == 0 ? stf : stb;
#pragma unroll
        for (int mt = 0; mt < 8; ++mt) { const int dv = wr * 128 + mt * 16 + fr, dk = wc * 32 + 8 * fq;
            *(GAS v4u*)(st + (size_t)dv * 128 + dk) = pack8(acc[mt][0], acc[mt][1]); }
    }
    __syncthreads();
}
__device__ __forceinline__ void p3a_sgu_fill(LAS unsigned char* lds, const v4u (&a0)[4], const v4u (&a1)[4], v4u (&ug)[4][2], const bf16* GU0, const float* vstat, const float* sgw, const int g, int tid, int wave, int lane) {
    LAS unsigned char* WI = lds; LAS unsigned char* VT = lds + 32768; LAS float* S12 = (LAS float*)(lds + 98304); LAS float* ST = (LAS float*)(lds + LNP_OFF);
    const int wr = wave >> 2, wc = wave & 3; int fr = lane & 15, fq = lane >> 4; asm volatile("" : "+v"(fr), "+v"(fq), "+v"(tid), "+v"(lane));
    f32x4 w0[4], w1[4]; f32x4 sv[8];
    if (tid < 128) {
#pragma unroll
        for (int i = 0; i < 8; ++i) sv[i] = *(const GAS f32x4*)(vstat + (size_t)tid * 32 + 4 * i); }
#pragma unroll
    for (int i = 0; i < 4; ++i) { const int idx = tid + 512 * i, p = idx >> 4, ch = idx & 15;
        w0[i] = *(const GAS f32x4*)(sgw + (size_t)(g * 128 + p) * 128 + 8 * ch); w1[i] = *(const GAS f32x4*)(sgw + (size_t)(g * 128 + p) * 128 + 8 * ch + 4); }
#pragma unroll
    for (int mt = 0; mt < 4; ++mt)
#pragma unroll
        for (int p2 = 0; p2 < 2; ++p2) ug[mt][p2] = *(const GAS v4u*)(GU0 + (size_t)(wr * 64 + mt * 16 + fr) * 1024 + g * 256 + wc * 64 + p2 * 32 + 8 * fq);
    if (tid < 128) { float s = 0.f, q = 0.f;
#pragma unroll
        for (int i = 0; i < 8; ++i) { s += sv[i][0] + sv[i][2]; q += sv[i][1] + sv[i][3]; }
        const float mean = s * (1.f / 1024.f), var = q * (1.f / 1024.f) - mean * mean;
        ST[2 * tid] = mean; ST[2 * tid + 1] = 1.f / sqrtf(var + LN_EPS); }
    __syncthreads();
#pragma unroll
    for (int i = 0; i < 4; ++i) { const int idx = tid + 512 * i, p = idx >> 4, ch = idx & 15;
        const f32x4 t0 = *(const LAS f32x4*)(ST + 16 * ch), t1 = *(const LAS f32x4*)(ST + 16 * ch + 4), t2 = *(const LAS f32x4*)(ST + 16 * ch + 8), t3 = *(const LAS f32x4*)(ST + 16 * ch + 12);
        float wv[8] = {w0[i][0], w0[i][1], w0[i][2], w0[i][3], w1[i][0], w1[i][1], w1[i][2], w1[i][3]};
        const float mu[8] = {t0[0], t0[2], t1[0], t1[2], t2[0], t2[2], t3[0], t3[2]}, rs[8] = {t0[1], t0[3], t1[1], t1[3], t2[1], t2[3], t3[1], t3[3]};
        float s1 = 0.f, s2 = 0.f;
#pragma unroll
        for (int j = 0; j < 8; ++j) { s2 += wv[j]; wv[j] *= rs[j]; s1 += wv[j] * mu[j]; }
#pragma unroll
        for (int o = 1; o < 16; o <<= 1) { s1 += __shfl_xor(s1, o); s2 += __shfl_xor(s2, o); }
        if (ch == 0) { S12[2 * p] = s1; S12[2 * p + 1] = s2; }
        v4u o; o.x = pk2(wv[0], wv[1]); o.y = pk2(wv[2], wv[3]); o.z = pk2(wv[4], wv[5]); o.w = pk2(wv[6], wv[7]);
        *(LAS v4u*)(WI + img_off(p, ch)) = o; }
    stage_T_write<32>(VT, a0, a1, wave, lane);
    __syncthreads();
}
__device__ __forceinline__ void p3a_sgu_finish(LAS unsigned char* lds, const v4u (&ug)[4][2], bf16* GU0, const float* lnw, const float* lnb, const float* sgb, const int g, int wave, int lane) {
    LAS unsigned char* WI = lds; LAS unsigned char* VT = lds + 32768; LAS float* S12 = (LAS float*)(lds + 98304);
    const int wr = wave >> 2, wc = wave & 3; int fr = lane & 15, fq = lane >> 4; asm volatile("" : "+v"(fr), "+v"(fq));
    f32x4 lw[4], lb[4]; float bps[4];
#pragma unroll
    for (int nt = 0; nt < 4; ++nt) { const int c = g * 256 + wc * 64 + 32 * (nt >> 1) + 8 * fq + 4 * (nt & 1); lw[nt] = *(const GAS f32x4*)(lnw + c); lb[nt] = *(const GAS f32x4*)(lnb + c); }
#pragma unroll
    for (int mt = 0; mt < 4; ++mt) bps[mt] = sgb[g * 128 + wr * 64 + mt * 16 + fr];
    f32x4 acc[4][4]; zero_acc<4, 4>(acc);
    mm_lds<4, 4>(acc, WI, wr * 64, VT, wc * 64, fr, fq);
#pragma unroll
    for (int mt = 0; mt < 4; ++mt) { const int p = wr * 64 + mt * 16 + fr; const float bp = bps[mt], s1 = S12[2 * p], s2 = S12[2 * p + 1];
#pragma unroll
        for (int p2 = 0; p2 < 2; ++p2) { f32x4 u0, u1; unpack8f(ug[mt][p2], u0, u1);
            const f32x4 o0 = (lw[2 * p2] * (acc[mt][2 * p2] - s1) + lb[2 * p2] * s2 + bp) * u0, o1 = (lw[2 * p2 + 1] * (acc[mt][2 * p2 + 1] - s1) + lb[2 * p2 + 1] * s2 + bp) * u1;
            *(GAS v4u*)(GU0 + (size_t)p * 1024 + g * 256 + wc * 64 + p2 * 32 + 8 * fq) = pack8(o0, o1); } }
    __syncthreads();
}
__device__ __forceinline__ bf16* st_slot(unsigned char* ws, int dir, int bh, int j) {
    return j < 2 ? (bf16*)(ws + (dir ? WS_STCB : WS_STCF)) + (size_t)(bh * 2 + j) * 32768 : (bf16*)(ws + (dir ? WS_STB : WS_STF)) + (size_t)(bh * 64 + (j - 2)) * 32768;
}
__device__ __forceinline__ void p3b_scan(unsigned char* ws, const float* decf, const float* decb, int gt) {
    const int dir = gt >> 16, bh = (gt >> 13) & 7, e = (gt & 8191) * 4; const int h = bh & 3;
    const float dec = dir ? decb[h] : decf[h]; const float cd = expf(-128.f * log1pf(expf(-dec)));
    f32x4 S = (f32x4){0.f, 0.f, 0.f, 0.f};
    for (int bt = 0; bt < 6; ++bt) {
        unsigned long long v[11]; GAS unsigned long long* p[11];
#pragma unroll
        for (int k = 0; k < 11; ++k) { const int i = bt * 11 + k; const int j = dir == 0 ? i : (i == 0 ? 1 : (i == 1 ? 0 : 67 - i));
            p[k] = (GAS unsigned long long*)(st_slot(ws, dir, bh, j) + e); v[k] = *p[k]; }
#pragma unroll
        for (int k = 0; k < 11; ++k) { const unsigned long long u = v[k];
            f32x4 t; t[0] = bf2f((bf16)(u & 0xffff)); t[1] = bf2f((bf16)((u >> 16) & 0xffff)); t[2] = bf2f((bf16)((u >> 32) & 0xffff)); t[3] = bf2f((bf16)(u >> 48));
            *p[k] = pack4(S); S = S * cd + t; }
    }
}
__device__ __forceinline__ void p3c_unit(LAS unsigned char* lds, const bf16* Q0, const bf16* K0, const bf16* V0, const bf16* stf, const bf16* stb, bf16* SG0,
                                         const float* gnw, const float* gnb, float lgf, float lgb, int tid, int wave, int lane) {
    LAS unsigned char* QS = lds; LAS unsigned char* KS = lds + 32768; LAS unsigned char* VT = lds + 65536;
    LAS float* PF = (LAS float*)(lds + TBL_OFF); LAS float* PB = PF + 132; LAS float* LNP = (LAS float*)(lds + LNP_OFF);
    const int wr = wave >> 2, wc = wave & 3; int fr = lane & 15, fq = lane >> 4; asm volatile("" : "+v"(fr), "+v"(fq), "+v"(tid), "+v"(lane));
    { v4u q[4], k[4], a0[4], a1[4];
      rows128_load(q, Q0, tid); rows128_load(k, K0, tid); stage_T_load<32, true>(a0, a1, V0, wave, lane);
      if (tid < 129) PF[tid] = expf((float)tid * lgf); else if (tid >= 256 && tid < 256 + 129) PB[tid - 256] = expf((float)(tid - 256) * lgb);
      rows128_write(QS, q, tid); rows128_write(KS, k, tid); stage_T_write<32>(VT, a0, a1, wave, lane); }
    __syncthreads();
    f32x4 sc[4][2]; zero_acc<4, 2>(sc);
    mm_lds<4, 2>(sc, QS, wr * 64, KS, wc * 32, fr, fq);
    v4u sst[8]; rows256_load(sst, stf, tid);
    __syncthreads();
#pragma unroll
    for (int mt = 0; mt < 4; ++mt) { const int l = wr * 64 + mt * 16 + fr; f32x4 v[2];
#pragma unroll
        for (int nt = 0; nt < 2; ++nt) { const int m0 = wc * 32 + 8 * fq + 4 * nt;
#pragma unroll
            for (int i = 0; i < 4; ++i) { const int d = l - (m0 + i); const float mk = (d >= 0 ? PF[d >= 0 ? d : 0] : 0.f) + (d <= 0 ? PB[d <= 0 ? -d : 0] : 0.f); v[nt][i] = sc[mt][nt][i] * mk; } }
        *(LAS v4u*)(KS + img_off(l, wc * 4 + fq)) = pack8(v[0], v[1]); }
    __syncthreads();
    f32x4 o[4][4]; zero_acc<4, 4>(o);
    mm_lds<4, 4>(o, KS, wr * 64, VT, wc * 64, fr, fq);
    __syncthreads();
    rows256_write(VT, sst, tid);
    rows256_load(sst, stb, tid);
    __syncthreads();
    {
        f32x4 p[4][4]; zero_acc<4, 4>(p);
        mm_lds<4, 4>(p, QS, wr * 64, VT, wc * 64, fr, fq);
#pragma unroll
        for (int mt = 0; mt < 4; ++mt) { const float s = PF[wr * 64 + mt * 16 + fr + 1];
#pragma unroll
            for (int nt = 0; nt < 4; ++nt) o[mt][nt] += p[mt][nt] * s; }
        __syncthreads();
        rows256_write(VT, sst, tid);
        __syncthreads();
        zero_acc<4, 4>(p);
        mm_lds<4, 4>(p, QS, wr * 64, VT, wc * 64, fr, fq);
#pragma unroll
        for (int mt = 0; mt < 4; ++mt) { const float s = PB[128 - (wr * 64 + mt * 16 + fr)];
#pragma unroll
            for (int nt = 0; nt < 4; ++nt) o[mt][nt] += p[mt][nt] * s; }
    }
#pragma unroll
    for (int mt = 0; mt < 4; ++mt) { float s = 0.f, q = 0.f;
#pragma unroll
        for (int nt = 0; nt < 4; ++nt)
#pragma unroll
            for (int i = 0; i < 4; ++i) { const float x = o[mt][nt][i]; s += x; q += x * x; }
        s += __shfl_xor(s, 16); s += __shfl_xor(s, 32); q += __shfl_xor(q, 16); q += __shfl_xor(q, 32);
        if (fq == 0) { const int l = wr * 64 + mt * 16 + fr; LNP[(l * 4 + wc) * 2] = s; LNP[(l * 4 + wc) * 2 + 1] = q; } }
    f32x4 gw4[4], gb4[4]; v4u ug[4][2];
#pragma unroll
    for (int nt = 0; nt < 4; ++nt) { const int dv = wc * 64 + 32 * (nt >> 1) + 8 * fq + 4 * (nt & 1); gw4[nt] = *(const GAS f32x4*)(gnw + dv); gb4[nt] = *(const GAS f32x4*)(gnb + dv); }
#pragma unroll
    for (int mt = 0; mt < 4; ++mt)
#pragma unroll
        for (int p2 = 0; p2 < 2; ++p2) ug[mt][p2] = *(const GAS v4u*)(SG0 + (size_t)(wr * 64 + mt * 16 + fr) * 1024 + wc * 64 + p2 * 32 + 8 * fq);
    __syncthreads();
#pragma unroll
    for (int mt = 0; mt < 4; ++mt) { const int l = wr * 64 + mt * 16 + fr; float s = 0.f, q = 0.f;
#pragma unroll
        for (int w = 0; w < 4; ++w) { s += LNP[(l * 4 + w) * 2]; q += LNP[(l * 4 + w) * 2 + 1]; }
        const float mean = s * (1.f / 256.f), rstd = 1.f / sqrtf(q * (1.f / 256.f) - mean * mean + LN_EPS);
#pragma unroll
        for (int p2 = 0; p2 < 2; ++p2) { f32x4 u0, u1; unpack8f(ug[mt][p2], u0, u1);
            const f32x4 y0 = ((o[mt][2 * p2] - mean) * rstd * gw4[2 * p2] + gb4[2 * p2]) * u0, y1 = ((o[mt][2 * p2 + 1] - mean) * rstd * gw4[2 * p2 + 1] + gb4[2 * p2 + 1]) * u1;
            *(GAS v4u*)(SG0 + (size_t)l * 1024 + wc * 64 + p2 * 32 + 8 * fq) = pack8(y0, y1); } }
    __syncthreads();
}

constexpr size_t WS_Y = WS_Q;
constexpr size_t WS_H2 = WS_V;
__device__ __forceinline__ int rimg(int row, int c) { return row * 2048 + ((c ^ (row & 15)) << 4); }
__device__ __forceinline__ float row_max16(float v) {
    v = fmaxf(v, WS_DPP(v, 0xB1, 0xF, true)); v = fmaxf(v, WS_DPP(v, 0x4E, 0xF, true)); v = fmaxf(v, WS_DPP(v, 0x141, 0xF, true)); v = fmaxf(v, WS_DPP(v, 0x140, 0xF, true));
    return v;
}
__device__ __forceinline__ float row_sum16b(float v) {
    v += WS_DPP(v, 0xB1, 0xF, true); v += WS_DPP(v, 0x4E, 0xF, true); v += WS_DPP(v, 0x141, 0xF, true); v += WS_DPP(v, 0x140, 0xF, true);
    return v;
}
__device__ __forceinline__ void p4c_rows(const int ROWS, const float* xrow0, float* ln1s, bf16* hrow0, float* aff_b, const int tok0, const LAS float* par,
                                         LAS unsigned char* lds, const bf16x8 (&bh)[4], const bf16x8 (&bl)[4], const float* br, int wave, int lane) {
  LAS unsigned char* AH = lds; LAS unsigned char* AL = lds + 32768; LAS float* RED = (LAS float*)(lds + 81920);
  const int fr = lane & 15, fq = lane >> 4;
  f32x4 cur[2][4], nxt[2][4];
  f32x4 PW[4], PB[4], PA[4], PS[4];
#pragma unroll
  for (int j = 0; j < 4; ++j) { const LAS f32x4* q = (const LAS f32x4*)par + lane + 64 * j; PW[j] = q[0]; PB[j] = q[256]; PA[j] = q[512]; PS[j] = q[768]; }
#pragma unroll
  for (int r = 0; r < 2; ++r)
#pragma unroll
    for (int j = 0; j < 4; ++j) cur[r][j] = __builtin_nontemporal_load((const GAS f32x4*)(xrow0 + (size_t)r * D) + lane + 64 * j);
#pragma unroll 1
  for (int t = 0; t < ROWS; t += 2) {
    if (t + 2 < ROWS) {
#pragma unroll
      for (int r = 0; r < 2; ++r)
#pragma unroll
        for (int j = 0; j < 4; ++j) nxt[r][j] = __builtin_nontemporal_load((const GAS f32x4*)(xrow0 + (size_t)(t + 2 + r) * D) + lane + 64 * j); }
#pragma unroll
    for (int r = 0; r < 2; ++r) {
      f32x4 v[4]; float s = 0.f;
#pragma unroll
      for (int j = 0; j < 4; ++j) { v[j] = cur[r][j]; s += (v[j].x + v[j].y) + (v[j].z + v[j].w); }
      float mean = wave_sum(s) * (1.f / D), s2 = 0.f;
#pragma unroll
      for (int j = 0; j < 4; ++j) { v[j] = v[j] - mean; s2 += (v[j].x * v[j].x + v[j].y * v[j].y) + (v[j].z * v[j].z + v[j].w * v[j].w); }
      float rstd = 1.f / sqrtf(wave_sum(s2) * (1.f / D) + LN_EPS);
      s = 0.f;
#pragma unroll
      for (int j = 0; j < 4; ++j) {
          v[j] = v[j] * rstd * PW[j] + PB[j]; s += (v[j].x + v[j].y) + (v[j].z + v[j].w); }
      if (lane == 0) { ln1s[2 * (t + r)] = mean; ln1s[2 * (t + r) + 1] = rstd; }
      mean = wave_sum(s) * (1.f / D); s2 = 0.f;
#pragma unroll
      for (int j = 0; j < 4; ++j) { v[j] = v[j] - mean; s2 += (v[j].x * v[j].x + v[j].y * v[j].y) + (v[j].z * v[j].z + v[j].w * v[j].w); }
      rstd = 1.f / sqrtf(wave_sum(s2) * (1.f / D) + LN_EPS);
      GAS unsigned long long* o8 = (GAS unsigned long long*)(hrow0 + (size_t)(t + r) * D) + lane;
      const int R = 2 * wave + r;
#pragma unroll
      for (int j = 0; j < 4; ++j) {
          v[j] = v[j] * rstd * PA[j] + PS[j];
          const unsigned h0 = pk2(v[j].x, v[j].y), h1 = pk2(v[j].z, v[j].w);
          o8[64 * j] = (unsigned long long)h0 | ((unsigned long long)h1 << 32);
          const float lx = v[j].x - __builtin_bit_cast(float, h0 << 16), ly = v[j].y - __builtin_bit_cast(float, h0 & 0xffff0000u), lz = v[j].z - __builtin_bit_cast(float, h1 << 16), lw = v[j].w - __builtin_bit_cast(float, h1 & 0xffff0000u);
          const unsigned l0 = pk2(lx, ly), l1 = pk2(lz, lw);
          const int off = rimg(R, (lane >> 1) + 32 * j) + 8 * (lane & 1);
          *(LAS unsigned long long*)(AH + off) = (unsigned long long)h0 | ((unsigned long long)h1 << 32);
          *(LAS unsigned long long*)(AL + off) = (unsigned long long)l0 | ((unsigned long long)l1 << 32); }
      asm volatile("" ::: "memory");
    }
    __syncthreads();
    { f32x4 acc = (f32x4){0.f, 0.f, 0.f, 0.f};
#pragma unroll
      for (int ks = 0; ks < 4; ++ks) { const int c = 16 * wave + 4 * ks + fq;
          const bf16x8 ah = *(const LAS bf16x8*)(AH + rimg(fr, c)), al = *(const LAS bf16x8*)(AL + rimg(fr, c));
          acc = __builtin_amdgcn_mfma_f32_16x16x32_bf16(bh[ks], ah, acc, 0, 0, 0);
          acc = __builtin_amdgcn_mfma_f32_16x16x32_bf16(bl[ks], ah, acc, 0, 0, 0);
          acc = __builtin_amdgcn_mfma_f32_16x16x32_bf16(bh[ks], al, acc, 0, 0, 0); }
      *(LAS f32x4*)(RED + wave * 256 + fr * 16 + 4 * fq) = acc; }
    __syncthreads();
    { const int r = (lane >> 4) & 1, e = lane & 15, R = 2 * wave + r; float lgt = br[e];
#pragma unroll
      for (int q = 0; q < 8; ++q) lgt += RED[q * 256 + R * 16 + e];
      const float mx = row_max16(lgt); const float ex = expf(lgt - mx); const float sum = row_sum16b(ex);
      if (lane < 32) aff_b[(size_t)e * T + tok0 + t + r] = ex / sum; }
#pragma unroll
    for (int r = 0; r < 2; ++r)
#pragma unroll
      for (int j = 0; j < 4; ++j) cur[r][j] = nxt[r][j];
  }
}

constexpr size_t WS_AFFT = 6 * MiB;
constexpr size_t WS_IDX = 7 * MiB;
constexpr size_t WS_GATEW = 7 * MiB + 512 * 1024;
constexpr size_t WS_SLOT = 8 * MiB;
constexpr size_t WS_X1 = 130 * MiB;
constexpr size_t WS_WD = 194 * MiB;
constexpr size_t WS_HID = 226 * MiB;
constexpr size_t WS_YE = 18 * MiB;
__device__ __forceinline__ unsigned block_excl_scan(unsigned v, LAS unsigned* wsum, int wave, int lane) {
    unsigned inc = v;
#pragma unroll
    for (int o = 1; o < 64; o <<= 1) { const unsigned t = __shfl_up(inc, o); if (lane >= o) inc += t; }
    if (lane == 63) wsum[wave] = inc;
    __syncthreads();
    unsigned base = 0;
#pragma unroll
    for (int w = 0; w < 8; ++w) base += (w < wave) ? wsum[w] : 0u;
    __syncthreads();
    return base + inc - v;
}
__device__ __forceinline__ void p5_topk(LAS unsigned char* lds, const float* aff, int* idx, float* gatew, int* slot, int tid, int wave, int lane) {
    LAS unsigned* wsum = (LAS unsigned*)lds;
    unsigned key[16];
#pragma unroll
    for (int i = 0; i < 4; ++i) { const f32x4 v = *((const GAS f32x4*)(aff + tid * 16) + i);
#pragma unroll
        for (int j = 0; j < 4; ++j) { const float f = v[j]; key[4 * i + j] = __float_as_uint(f); } }
    unsigned thr_ = 0u;
#pragma unroll 1
    for (int b0 = 30; b0 >= 0; b0 -= 2) {
        const unsigned t1 = thr_ + (1u << b0), t2 = thr_ + (2u << b0), t3 = thr_ + (3u << b0); unsigned p01 = 0u, p2 = 0u;
#pragma unroll
        for (int i = 0; i < 16; ++i) { p01 += (key[i] >= t1 ? 1u : 0u) + (key[i] >= t2 ? 0x10000u : 0u); p2 += (key[i] >= t3) ? 1u : 0u; }
        p01 = wave_sum_u(p01); p2 = wave_sum_u(p2);
        const int par = (b0 >> 1) & 1;
        if (lane == 0) { wsum[par * 16 + 2 * wave] = p01; wsum[par * 16 + 2 * wave + 1] = p2; }
        __syncthreads();
        unsigned n1 = 0u, n2 = 0u, n3 = 0u;
#pragma unroll
        for (int w = 0; w < 8; ++w) { const unsigned a = wsum[par * 16 + 2 * w], b = wsum[par * 16 + 2 * w + 1]; n1 += a & 0xffffu; n2 += a >> 16; n3 += b; }
        thr_ = n3 >= 1024u ? t3 : (n2 >= 1024u ? t2 : (n1 >= 1024u ? t1 : thr_));
    }
    __syncthreads();
    unsigned gt = 0u;
#pragma unroll
    for (int i = 0; i < 16; ++i) gt += (key[i] > thr_) ? 1u : 0u;
    gt = wave_sum_u(gt);
    if (lane == 0) wsum[32 + wave] = gt;
    __syncthreads();
    unsigned gtot = 0u;
#pragma unroll
    for (int w = 0; w < 8; ++w) gtot += wsum[32 + w];
    const unsigned prefix = thr_, need = 1024u - gtot;
    __syncthreads();
    const unsigned thr = prefix;
    unsigned eq = 0u;
#pragma unroll
    for (int i = 0; i < 16; ++i) eq += (key[i] == thr) ? 1u : 0u;
    unsigned e2 = block_excl_scan(eq, wsum, wave, lane);
    unsigned selmask = 0u, cnt = 0u;
#pragma unroll
    for (int i = 0; i < 16; ++i) { bool s = key[i] > thr; if (key[i] == thr) { s = e2 < need; ++e2; } if (s) { selmask |= 1u << i; ++cnt; } }
    unsigned base = block_excl_scan(cnt, wsum, wave, lane);
    LAS int* slotL = (LAS int*)(lds + 1024); LAS int* idxL = slotL + 8192; LAS float* gwL = (LAS float*)(idxL + 1024);
#pragma unroll
    for (int i = 0; i < 16; ++i) { const int t = tid * 16 + i;
        if ((selmask >> i) & 1u) { idxL[base] = t; gwL[base] = __builtin_bit_cast(float, key[i]); slotL[t] = (int)base; ++base; } else slotL[t] = -1; }
    __syncthreads();
    typedef int i32x4 __attribute__((ext_vector_type(4)));
#pragma unroll
    for (int q = 0; q < 4; ++q) *((GAS i32x4*)slot + tid + 512 * q) = *((const LAS i32x4*)slotL + tid + 512 * q);
    if (tid < 256) *((GAS i32x4*)idx + tid) = *((const LAS i32x4*)idxL + tid); else *((GAS f32x4*)gatew + (tid - 256)) = *((const LAS f32x4*)gwL + (tid - 256));
}
__device__ __forceinline__ void p8_gather(f32x4 (&acc)[4], const bf16* YE, int myslot, int b, int lane) {
#pragma unroll
    for (int j = 0; j < 4; ++j) acc[j] = (f32x4){0.f, 0.f, 0.f, 0.f};
    unsigned bal = (unsigned)__ballot(myslot >= 0 && lane < 16);
    while (bal) {
        const int e0 = __builtin_ctz(bal); bal &= bal - 1; const bool two = bal != 0u; const int e1 = two ? __builtin_ctz(bal) : e0; if (two) bal &= bal - 1;
        const int s0 = __shfl(myslot, e0), s1 = __shfl(myslot, e1);
        const GAS unsigned long long* y0 = (const GAS unsigned long long*)(YE + ((size_t)((b * 16 + e0) * 1024 + s0)) * 1024) + lane;
        const GAS unsigned long long* y1 = (const GAS unsigned long long*)(YE + ((size_t)((b * 16 + e1) * 1024 + s1)) * 1024) + lane;
        unsigned long long u0[4], u1[4];
#pragma unroll
        for (int j = 0; j < 4; ++j) { u0[j] = __builtin_nontemporal_load(y0 + 64 * j); u1[j] = __builtin_nontemporal_load(y1 + 64 * j); }
        const float f1 = two ? 1.f : 0.f;
#pragma unroll
        for (int j = 0; j < 4; ++j) { const unsigned long long u = u0[j], w = u1[j];
            acc[j][0] += bf2f((bf16)(u & 0xffff)) + f1 * bf2f((bf16)(w & 0xffff)); acc[j][1] += bf2f((bf16)((u >> 16) & 0xffff)) + f1 * bf2f((bf16)((w >> 16) & 0xffff));
            acc[j][2] += bf2f((bf16)((u >> 32) & 0xffff)) + f1 * bf2f((bf16)((w >> 32) & 0xffff)); acc[j][3] += bf2f((bf16)(u >> 48)) + f1 * bf2f((bf16)(w >> 48)); }
    }
}
__device__ __forceinline__ void p8_rows2(const float* xrow0, const float* ln1s, const float* l1w, const float* l1b, float* orow0, const bf16* YE, const int* slot_b, int t, int b, const float* g2, const float* l2w, const float* l2b, int lane) {
    const int sl0 = slot_b[(size_t)(lane & 15) * T + t], sl1 = slot_b[(size_t)(lane & 15) * T + t + 1];
    f32x4 x[2][4], g[4], w[4], bb[4];
#pragma unroll
    for (int r = 0; r < 2; ++r)
#pragma unroll
        for (int j = 0; j < 4; ++j) x[r][j] = __builtin_nontemporal_load((const GAS f32x4*)(xrow0 + (size_t)r * D) + lane + 64 * j);
#pragma unroll
    for (int j = 0; j < 4; ++j) { g[j] = *((const GAS f32x4*)g2 + lane + 64 * j); w[j] = *((const GAS f32x4*)l2w + lane + 64 * j); bb[j] = *((const GAS f32x4*)l2b + lane + 64 * j); }
    f32x4 w1[4], b1[4]; const f32x4 st = *(const GAS f32x4*)ln1s;
#pragma unroll
    for (int j = 0; j < 4; ++j) { w1[j] = *((const GAS f32x4*)l1w + lane + 64 * j); b1[j] = *((const GAS f32x4*)l1b + lane + 64 * j); }
    f32x4 acc[2][4];
    p8_gather(acc[0], YE, sl0, b, lane); p8_gather(acc[1], YE, sl1, b, lane);
#pragma unroll
    for (int r = 0; r < 2; ++r) {
        GAS f32x4* xr = (GAS f32x4*)(orow0 + (size_t)r * D) + lane;
        f32x4 v[4]; float s = 0.f;
#pragma unroll
        for (int j = 0; j < 4; ++j) { const f32x4 x1 = (x[r][j] - st[2 * r]) * st[2 * r + 1] * w1[j] + b1[j]; v[j] = x1 * ALPHA + g[j] * acc[r][j]; s += (v[j].x + v[j].y) + (v[j].z + v[j].w); }
        const float mean = wave_sum(s) * (1.f / D); float s2 = 0.f;
#pragma unroll
        for (int j = 0; j < 4; ++j) { v[j] = v[j] - mean; s2 += (v[j].x * v[j].x + v[j].y * v[j].y) + (v[j].z * v[j].z + v[j].w * v[j].w); }
        const float rstd = 1.f / sqrtf(wave_sum(s2) * (1.f / D) + LN_EPS);
#pragma unroll
        for (int j = 0; j < 4; ++j) __builtin_nontemporal_store(v[j] * rstd * w[j] + bb[j], xr + 64 * j);
    }
}

#define MOE_ITEM(ID, Wp, WTp, k0v, n0v, dnv) const int _id = (ID); const int _g = _id < 16384; const int _it = _g ? _id : _id - 16384; const int _mat = _g ? (_it >> 13) : 2; \
    const int _e = (_it >> 9) & 15, _q = _it & 511; const int k0v = 64 * (_q >> 5), n0v = 32 * (_q & 31); \
    const float* Wp = (_mat == 0 ? args.in[24] : _mat == 1 ? args.in[25] : args.in[26]) + (size_t)_e * D * D; \
    bf16* WTp = _g ? (bf16*)args.out + (size_t)_e * 2048 * 1024 : (bf16*)(ws + WS_WD) + (size_t)_e * 1024 * 1024; \
    const int dnv = _g ? 256 * (n0v >> 7) + (n0v & 127) + 128 * _mat : n0v
#define MOE_COPY_LOOP(lo, hi) do { f32x4 wv[8], wn[8]; int it = (lo) + cw; \
        if (it < (hi)) { MOE_ITEM(it, W_, WT_, k0_, n0_, dn_); (void)WT_; (void)dn_; p0_tr_load(wv, W_, D, k0_, n0_, lane); } \
        for (; it < (hi); it += NCW) { const int itn = it + NCW; \
            if (itn < (hi)) { MOE_ITEM(itn, Wn_, WTn_, k0n_, n0n_, dnn_); (void)WTn_; (void)dnn_; p0_tr_load(wn, Wn_, D, k0n_, n0n_, lane); } \
            { MOE_ITEM(it, W_, WT_, k0_, n0_, dn_); (void)W_; (void)n0_; p0_tr_finish<true>(wv, D, WT_, k0_, dn_, scr, lane); } \
            _Pragma("unroll") for (int i = 0; i < 8; ++i) wv[i] = wn[i]; } } while (0)
#define MOE_COPY_STREAM(ID0, STRIDE, K0, KSTEP, KEND, STOP, KOUT) do { f32x4 wv[8], wn[8]; int k = (K0); \
        if (k < (KEND)) { MOE_ITEM((ID0) + (STRIDE) * k, W_, WT_, k0_, n0_, dn_); (void)WT_; (void)dn_; p0_tr_load(wv, W_, D, k0_, n0_, lane); } \
        while (k < (KEND)) { const bool stop_ = (STOP); const int kn = k + (KSTEP); \
            if (kn < (KEND) && !stop_) { MOE_ITEM((ID0) + (STRIDE) * kn, Wn_, WTn_, k0n_, n0n_, dnn_); (void)WTn_; (void)dnn_; p0_tr_load(wn, Wn_, D, k0n_, n0n_, lane); } \
            { MOE_ITEM((ID0) + (STRIDE) * k, W_, WT_, k0_, n0_, dn_); (void)W_; (void)n0_; p0_tr_finish<true>(wv, D, WT_, k0_, dn_, scr, lane); } \
            k = kn; if (stop_) break; _Pragma("unroll") for (int i = 0; i < 8; ++i) wv[i] = wn[i]; } (KOUT) = k; } while (0)
constexpr int NCS = 192, CS_ITEMS = 24576 / NCS;
constexpr int CS_P2 = 73, CS_GU = 85, POOLB0 = NCS * CS_P2, POOLB_WGS = 36;
static_assert(NCS * CS_GU <= 16384 && POOLB0 + POOLB_WGS * NWAVES * 8 == NCS * CS_GU, "P2 converts gate / up items only");
constexpr int P2_TAIL_ITEMS = 9728;
__global__ void __launch_bounds__(NWAVES * 64, 2) mk_fwd(Args args) {
    extern __shared__ __attribute__((aligned(16))) unsigned char lds_raw[];
    LAS unsigned char* lds = (LAS unsigned char*)lds_raw;
    volatile LAS unsigned* MISC = (volatile LAS unsigned*)(lds + MISC_OFF);
    const int tid = threadIdx.x, lane = tid & 63, wave = __builtin_amdgcn_readfirstlane(tid >> 6);
    const int G = gridDim.x; const int bx = blockIdx.x; const int vcu = (G % 8 == 0) ? (bx % 8) * (G / 8) + bx / 8 : bx;
    unsigned char* ws = args.ws;
    gu32* ctl = (gu32*)(ws + WS_CTL);
    for (int u = tid; u < (LDS_BYTES - LDSCTL_OFF) / 4; u += NWAVES * 64) ((LAS unsigned*)(lds + LDSCTL_OFF))[u] = 0u;
    __syncthreads();
    XcdBarrier bar = xcd_barrier_post((unsigned*)(ctl + CW_BAR) + args.li * XCD_BAR_WORDS, MISC + 8);
    const int lo = args.ph_lo, hi = args.ph_hi;
#ifdef PH_ONLY
#define PHON(k) ((k) == PH_ONLY)
#else
#define PHON(k) true
#endif
#define IN(k) (lo <= (k) && (k) < hi)
#ifdef DIAG_A
#define STAMP(k) do { if (blockIdx.x == 0 && tid == 0) { ((unsigned long long*)(ws + 768 * 1024))[(k)] = rt(); } } while (0)
#else
#define STAMP(k) do {} while (0)
#endif
#define BOTH(k) (IN(k) && IN((k) + 1))
    const int gw = vcu * NWAVES + wave, NGW = G * NWAVES;
    STAMP(0);
    if (PHON(0) && IN(0)) { p0_prologue(args, lds, gw, NGW, wave, lane, tid); if (BOTH(0)) xcd_barrier(bar); STAMP(0 + 1); }
    if (PHON(1) && IN(1)) {
        const float* MOD = (const float*)(ws + WS_MOD); bf16* H = (bf16*)(ws + WS_H);
        for (int m0 = gw * 2; m0 < M; m0 += NGW * 2) {
            const float* xr[2]; bf16* orr[2]; const int bb = m0 >> 13;
#pragma unroll
            for (int r = 0; r < 2; ++r) { const int m = m0 + r; xr[r] = args.in[0] + (size_t)m * D; orr[r] = H + (size_t)m * D; }
            p1_rows<2>(xr, orr, MOD + bb * 6144, MOD + bb * 6144 + D, lane);
        }
        for (int mc = gw; mc < MC; mc += NGW) {
            const float* xr[1] = {args.in[2] + (size_t)mc * D}; bf16* orr[1] = {H + (size_t)(M + mc) * D};
            p1_rows<1>(xr, orr, MOD + 2 * 6144, MOD + 2 * 6144 + D, lane);
        }
        if (BOTH(1)) xcd_barrier(bar); STAMP(1 + 1);
    }
    if (PHON(2) && IN(2)) {
        unsigned* ctxflag = (unsigned*)(ws + WS_CTL) + 1024;
        unsigned* p2done = ctxflag + 32; unsigned* cprog = ctxflag + 1024;
        const bool split = (G == 256);
        if (split && (int)blockIdx.x >= pg8::NG2) {
            LAS float* scr = (LAS float*)(lds + RING_OFF + wave * 16384);
            const int w = ((int)blockIdx.x - pg8::NG2) * NWAVES + wave; int kdone = 0;
            MOE_COPY_STREAM(w, NCS, 0, 1, CS_P2, __hip_atomic_load(p2done, __ATOMIC_RELAXED, __HIP_MEMORY_SCOPE_AGENT) >= 60u, kdone);
            if (lane == 0) cprog[w] = (unsigned)kdone;
        } else {
        pg8::SchedP2 S; S.init(split ? pg8::NG2 : G, (int)blockIdx.x, ws + WS_H, ws + WS_WIN, ctxflag, split);
        static_assert(WS_K == WS_Q + 16 * MiB && WS_SG == WS_V + 32 * MiB && WS_GU == WS_V + 64 * MiB && WS_GVS == WS_V + 96 * MiB && WS_SGA == WS_V + 128 * MiB && WS_SGB == WS_V + 160 * MiB, "section spacing");
        pg8::EpiZ E{(bf16*)(ws + WS_Q), (bf16*)(ws + WS_V), (bf16*)(ws + WS_KC), (bf16*)(ws + WS_VC), args.in[7], (const float*)(ws + WS_TAB), (float*)(ws + WS_VSTAT)};
        pg8::gemm_phase<pg8::EpiZ, pg8::SchedP2, true, true>(lds + RING_OFF, D, S, E);
        if (split) {
            if (tid == 0) __hip_atomic_fetch_add(p2done, 1u, __ATOMIC_RELAXED, __HIP_MEMORY_SCOPE_AGENT);
            const int ti = (int)blockIdx.x - (pg8::CF0 + 12);
            if (ti >= 0 && ti < 16) {
                if (tid == 0) { unsigned sp = 0;
                    while (__hip_atomic_load(ctxflag, __ATOMIC_RELAXED, __HIP_MEMORY_SCOPE_AGENT) < 12u) { __builtin_amdgcn_s_sleep(8); if (++sp > (1u << 22)) { __hip_atomic_store((unsigned*)(ws + WS_CTL) + CW_TMO, 1u, __ATOMIC_RELAXED, __HIP_MEMORY_SCOPE_AGENT); break; } }
                    __builtin_amdgcn_fence(__ATOMIC_ACQUIRE, "agent"); asm volatile("s_waitcnt vmcnt(0)" ::: "memory"); }
                __syncthreads();
                const int cu = ti, bh = cu >> 1, j = cu & 1, h = bh & 3; const float* decf = args.in[8]; const float* decb = args.in[9];
                const float lgf = -log1pf(expf(-decf[h])), lgb = -log1pf(expf(-decb[h]));
                v4u A0[4], A1[4], K0[2], K1[2];
                stage_T_load<32>(A0, A1, (const bf16*)(ws + WS_VC) + (size_t)cu * 32768, wave, lane); stage_T_load<16>(K0, K1, (const bf16*)(ws + WS_KC) + (size_t)cu * 16384, wave, lane);
                p3a_kv_fill(lds, A0, A1, K0, K1, lgf, lgb, wave, lane);
                p3a_kv_finish(lds, st_slot(ws, 0, bh, j), st_slot(ws, 1, bh, j), wave, lane);
            } else if (ti >= 16 && ti < 16 + POOLB_WGS) {
                LAS float* scr = (LAS float*)(lds + RING_OFF + wave * 16384);
                const int bw = (ti - 16) * NWAVES + wave; int kd_ = 0;
                MOE_COPY_STREAM(POOLB0 + bw, POOLB_WGS * NWAVES, 0, 1, 8, false, kd_); (void)kd_;
            } } }
        if (BOTH(2)) xcd_barrier(bar); STAMP(2 + 1);
    }

    if (PHON(3) && IN(3)) {
        const float* decf = args.in[8]; const float* decb = args.in[9];
        v4u A0[4], A1[4], K0[2], K1[2];
#define P3A_PREFETCH(LL) do { const int _L = (LL); \
            if (_L < 512) { stage_T_load<32, true>(A0, A1, (const bf16*)(ws + WS_GVS) + (size_t)((((_L >> 8) * 64 + ((_L >> 2) & 63)) * 4 + (_L & 3))) * 32768, wave, lane); } \
            else { const int _u = _L - 512; const bf16* _Ks; const bf16* _Vs; \
                if (_u < 512) { _Ks = (const bf16*)(ws + WS_K) + (size_t)_u * 16384; _Vs = (const bf16*)(ws + WS_V) + (size_t)_u * 32768; }        \
                else { const int _cu = _u - 512; _Ks = (const bf16*)(ws + WS_KC) + (size_t)_cu * 16384; _Vs = (const bf16*)(ws + WS_VC) + (size_t)_cu * 32768; }     \
                stage_T_load<32>(A0, A1, _Vs, wave, lane); stage_T_load<16>(K0, K1, _Ks, wave, lane); } } while (0)
        const int NU3 = G == 256 ? 1024 : 1040;
        if (vcu < NU3) P3A_PREFETCH(vcu);
        for (int L = vcu; L < NU3; L += G) {
            if (L < 512) { const size_t r0 = (size_t)(L >> 8) * T + (size_t)((L >> 2) & 63) * 128; const int g = L & 3; bf16* GU0 = (bf16*)(ws + WS_GU) + r0 * 1024;
                v4u UG[4][2];
                p3a_sgu_fill(lds, A0, A1, UG, GU0, (const float*)(ws + WS_VSTAT) + r0 * 32, args.in[14], g, tid, wave, lane);
                if (L + G < NU3) P3A_PREFETCH(L + G);
                p3a_sgu_finish(lds, UG, GU0, args.in[12], args.in[13], args.in[15], g, wave, lane);
                continue; }
            const int u = L - 512; int bh, j;
            if (u < 512) { bh = u >> 6; j = (u & 63) + 2; } else { const int cu = u - 512; bh = cu >> 1; j = cu & 1; }
            const int h = bh & 3; const float lgf = -log1pf(expf(-decf[h])), lgb = -log1pf(expf(-decb[h]));
            p3a_kv_fill(lds, A0, A1, K0, K1, lgf, lgb, wave, lane);
            if (L + G < NU3) P3A_PREFETCH(L + G);
            p3a_kv_finish(lds, st_slot(ws, 0, bh, j), st_slot(ws, 1, bh, j), wave, lane);
        }
#undef P3A_PREFETCH
        if (BOTH(3)) xcd_barrier(bar); STAMP(3 + 1);
    }
    if (PHON(4) && IN(4)) {
        for (int gt = gw * 64 + lane; gt < 131072; gt += NGW * 64) p3b_scan(ws, args.in[8], args.in[9], gt);
        if (BOTH(4)) xcd_barrier(bar); STAMP(4 + 1);
    }
    if (PHON(5) && IN(5)) {
        const float* decf = args.in[8]; const float* decb = args.in[9];
        for (int u = vcu; u < 512; u += G) {
            const int bh = u >> 6, n = u & 63, h = bh & 3; const size_t r0 = (size_t)(bh >> 2) * T + (size_t)n * 128;
            const float lgf = -log1pf(expf(-decf[h])), lgb = -log1pf(expf(-decb[h]));
            p3c_unit(lds, (const bf16*)(ws + WS_Q) + (size_t)u * 16384, (const bf16*)(ws + WS_K) + (size_t)u * 16384, (const bf16*)(ws + WS_V) + (size_t)u * 32768,
                     st_slot(ws, 0, bh, n + 2), st_slot(ws, 1, bh, n + 2), (bf16*)(ws + WS_SG) + r0 * 1024 + h * 256, args.in[10] + h * 256, args.in[11] + h * 256, lgf, lgb, tid, wave, lane);
        }
        if (BOTH(5)) xcd_barrier(bar); STAMP(5 + 1);
    }

    if (PHON(6) && IN(6)) {
        pg8::SchedY S; S.init(M, D, G, (int)blockIdx.x, ws + WS_SG, ws + WS_WPA, ws + WS_GU, ws + WS_WPB);
        pg8::EpiY E{(const bf16*)(ws + WS_SGA), (const bf16*)(ws + WS_SGB), (bf16*)(ws + WS_Y)};
        pg8::gemm_phase<pg8::EpiY, pg8::SchedY, true, true>(lds + RING_OFF, D, S, E);
        if (BOTH(6)) xcd_barrier(bar); STAMP(6 + 1);
    }
    if (PHON(7) && IN(7)) {
        pg8::SchedN S; S.init(M, D, G, (int)blockIdx.x, ws + WS_Y, ws + WS_WO);
        pg8::EpiMix E{args.in[0], (const float*)(ws + WS_MOD), args.in[19], (float*)(ws + WS_X1)};
        pg8::gemm_phase<pg8::EpiMix, pg8::SchedN, true, true>(lds + RING_OFF, D, S, E);
        if (BOTH(7)) xcd_barrier(bar); STAMP(7 + 1);
    }
    if (PHON(8) && IN(8)) {
        LAS unsigned char* WH = lds + RING_OFF; LAS unsigned char* WL = lds + RING_OFF + 32768;
        { f32x4 wv[8];
#pragma unroll
          for (int i = 0; i < 8; ++i) wv[i] = *((const GAS f32x4*)args.in[22] + tid + 512 * i);
#pragma unroll
          for (int i = 0; i < 8; ++i) { const int f4 = tid + 512 * i, kk = f4 >> 2, e0 = (f4 & 3) * 4;
#pragma unroll
              for (int j = 0; j < 4; ++j) { const float w = wv[i][j]; const unsigned hl = pk2(w, 0.f) & 0xffffu; const float lo = w - __builtin_bit_cast(float, hl << 16);
                  const int off = rimg(e0 + j, kk >> 3) + 2 * (kk & 7);
                  *(LAS bf16*)(WH + off) = (bf16)hl; *(LAS bf16*)(WL + off) = (bf16)(pk2(lo, 0.f) & 0xffffu); } } }
        const float* MOD = (const float*)(ws + WS_MOD);
        LAS float* par = (LAS float*)(lds + RING_OFF + 65536);
        { const int b = (gw - wave) * (M / (G * NWAVES)) >> 13; const float* sh2 = MOD + b * 6144 + 3 * D; const float* sc2 = MOD + b * 6144 + 4 * D;
          for (int i = tid; i < 1024; i += NWAVES * 64) { par[i] = args.in[20][i]; par[1024 + i] = args.in[21][i]; par[2048 + i] = sc2[i] + 1.f; par[3072 + i] = sh2[i]; } }
        __syncthreads();
        bf16x8 bh[4], bl[4];
#pragma unroll
        for (int ks = 0; ks < 4; ++ks) { const int c = 16 * wave + 4 * ks + (lane >> 4); bh[ks] = *(const LAS bf16x8*)(WH + rimg(lane & 15, c)); bl[ks] = *(const LAS bf16x8*)(WL + rimg(lane & 15, c)); }
        __syncthreads();
        const int rpw = M / (G * NWAVES);
        { const int m = gw * rpw; const int b = m >> 13;
            p4c_rows(rpw, (const float*)(ws + WS_X1) + (size_t)m * D, (float*)(ws + WS_LN1S) + 2 * m, (bf16*)(ws + WS_H2) + (size_t)m * D, (float*)(ws + WS_AFFT) + (size_t)b * 16 * T, m & (T - 1), par,
                     lds + RING_OFF, bh, bl, args.in[23], wave, lane); }
        __syncthreads();
        if (BOTH(8)) xcd_barrier(bar); STAMP(8 + 1);
    }

    if (PHON(9) && IN(9)) {
        const int ntk = G > 64 ? 32 : 0;
        for (int be = vcu; be < 32; be += G) {
            p5_topk(lds, (const float*)(ws + WS_AFFT) + (size_t)be * T, (int*)(ws + WS_IDX) + be * 1024, (float*)(ws + WS_GATEW) + be * 1024, (int*)(ws + WS_SLOT) + (size_t)be * T, tid, wave, lane);
            __syncthreads(); }
        if (vcu >= ntk) {
            LAS float* scr = (LAS float*)(lds + RING_OFF + wave * 16384);
            const unsigned* cprog = (const unsigned*)(ws + WS_CTL) + 2048;
            const int pw = (vcu - ntk) * NWAVES + wave, NP = (G - ntk) * NWAVES; int kd_ = 0;
            const int ka = G == 256 ? CS_P2 : CS_ITEMS, kb = G == 256 ? CS_GU : CS_ITEMS;
            if (NP >= NCS) { const int w = pw % NCS, q = pw / NCS, nq = (NP - 1 - w) / NCS + 1;
                MOE_COPY_STREAM(w, NCS, (int)cprog[w] + q, nq, ka, false, kd_);
                MOE_COPY_STREAM(w, NCS, kb + q, nq, CS_ITEMS, false, kd_); }
            else for (int w = pw; w < NCS; w += NP) { MOE_COPY_STREAM(w, NCS, (int)cprog[w], 1, ka, false, kd_); MOE_COPY_STREAM(w, NCS, kb, 1, CS_ITEMS, false, kd_); }
            (void)kd_;
        }
        if (BOTH(9)) xcd_barrier(bar); STAMP(9 + 1);
    }
    if (PHON(10) && IN(10)) {
        pg8::SchedG1 S; S.init(G, vcu, ws + WS_H2, args.out, (const int*)(ws + WS_IDX));
        pg8::EpiH E{(bf16*)(ws + WS_HID)};
        pg8::gemm_phase<pg8::EpiH, pg8::SchedG1, true, true>(lds + RING_OFF, D, S, E);
        if (BOTH(10)) xcd_barrier(bar); STAMP(10 + 1);
    }
    if (PHON(11) && IN(11)) {
        pg8::SchedG2 S; S.init(G, vcu, ws + WS_HID, ws + WS_WD);
        pg8::EpiYE E{(bf16*)(ws + WS_YE), (const float*)(ws + WS_GATEW)};
        pg8::gemm_phase<pg8::EpiYE, pg8::SchedG2, true, true>(lds + RING_OFF, D, S, E);
        if (BOTH(11)) xcd_barrier(bar); STAMP(11 + 1);
    }
    if (PHON(12) && IN(12)) {
        const float* MOD = (const float*)(ws + WS_MOD);
        for (int m = gw * 2; m < M; m += NGW * 2) { const int b = m >> 13;
            p8_rows2((const float*)(ws + WS_X1) + (size_t)m * D, (const float*)(ws + WS_LN1S) + 2 * m, args.in[20], args.in[21], args.out + (size_t)m * D, (const bf16*)(ws + WS_YE), (const int*)(ws + WS_SLOT) + (size_t)b * 16 * T, m & (T - 1), b, MOD + b * 6144 + 5 * D, args.in[27], args.in[28], lane); }
#ifdef DIAG_A
        xcd_barrier(bar); STAMP(13); xcd_barrier(bar);
        { __syncthreads(); const unsigned long long* ts = (const unsigned long long*)(ws + 768 * 1024);
          const float da = (float)(__hip_atomic_load(ts + DIAG_A + 1, __ATOMIC_RELAXED, __HIP_MEMORY_SCOPE_AGENT) - __hip_atomic_load(ts + DIAG_A, __ATOMIC_RELAXED, __HIP_MEMORY_SCOPE_AGENT)) * 0.01f;
          const float db = (float)(__hip_atomic_load(ts + DIAG_B + 1, __ATOMIC_RELAXED, __HIP_MEMORY_SCOPE_AGENT) - __hip_atomic_load(ts + DIAG_B, __ATOMIC_RELAXED, __HIP_MEMORY_SCOPE_AGENT)) * 0.01f;
          const int rpw8 = M / (G * NWAVES);
          for (int m = gw; m < M; m += NGW) { GAS f32x4* xr = (GAS f32x4*)(args.out + (size_t)m * D) + lane;
              for (int j = 0; j < 4; ++j) { f32x4 v = xr[64 * j]; v = v * (1.f + da * DIAG_SCALE); (void)db; xr[64 * j] = v; } } (void)rpw8; }
#endif
    }
#undef IN
#undef BOTH
}

namespace nv {
constexpr float KSCALE = 0.08838834764831845f;
__device__ __forceinline__ float sigmoidf_(float x) { return 1.f / (1.f + expf(-x)); }
__device__ __forceinline__ float siluf_(float x) { return x * sigmoidf_(x); }

__global__ void k_rowln(const float* xin, const float* add, const float* gate, const float* lw, const float* lb,
                        float* out1, const float* sh, const float* sc, float* out2, float alpha, int rows) {
  int row = (blockIdx.x * blockDim.x + threadIdx.x) >> 6; int lane = threadIdx.x & 63;
  if (row >= rows) return;
  float v[16]; float s = 0.f;
#pragma unroll
  for (int i = 0; i < 16; ++i) { int cidx = lane + 64 * i; float t = alpha * xin[(size_t)row * D + cidx]; if (add) t += gate[cidx] * add[(size_t)row * D + cidx]; v[i] = t; s += t; }
  float mean = wave_sum(s) * (1.f / D); float q = 0.f;
#pragma unroll
  for (int i = 0; i < 16; ++i) { v[i] -= mean; q += v[i] * v[i]; }
  float rstd = rsqrtf(wave_sum(q) * (1.f / D) + LN_EPS);
#pragma unroll
  for (int i = 0; i < 16; ++i) { int cidx = lane + 64 * i; float y = v[i] * rstd; if (lw) y = y * lw[cidx] + lb[cidx];
    if (out1) out1[(size_t)row * D + cidx] = y; if (out2) out2[(size_t)row * D + cidx] = y * (1.f + sc[cidx]) + sh[cidx]; }
}
struct EpiStore { float* C; int ldc; int pad; const float* bias; long cBatch;
  __device__ void operator()(int z, int m, int n, float v) const { C[z * cBatch + (size_t)m * ldc + n] = v + (bias ? bias[n] : 0.f); } };
struct EpiGate2 { float* Y; const bf16* SGx; int accumulate; int pad;
  __device__ void operator()(int z, int m, int n, float v) const { float r = bf2f(SGx[(size_t)m * D + n]) * v; if (accumulate) r += Y[(size_t)m * D + n]; Y[(size_t)m * D + n] = r; } };
__device__ __forceinline__ float4 ld_a4(const float* p) { return *(const float4*)p; }
__device__ __forceinline__ float4 ld_a4(const bf16* p) { const uint2 u = *(const uint2*)p; return make_float4(bf2f((bf16)(u.x & 0xffff)), bf2f((bf16)(u.x >> 16)), bf2f((bf16)(u.y & 0xffff)), bf2f((bf16)(u.y >> 16))); }
template <class Epi, class AT>
__global__ __launch_bounds__(256) void ngemm(const AT* __restrict__ A, const int* __restrict__ gidx, const float* __restrict__ Bm,
                                             long aBatch, long bBatch, Epi epi, int lda, int ldb, int K, int gBatch) {
  __shared__ float As[16][68];
  __shared__ float Bs[16][68];
  const int z = blockIdx.z; A += z * aBatch; Bm += z * bBatch; if (gidx) gidx += z * gBatch;
  const int tid = threadIdx.x, tx = tid & 15, ty = tid >> 4;
  const int m0 = blockIdx.y * 64, n0 = blockIdx.x * 64;
  float acc[4][4];
#pragma unroll
  for (int i = 0; i < 4; ++i)
#pragma unroll
    for (int j = 0; j < 4; ++j) acc[i][j] = 0.f;
  const int ar = tid >> 2, ak = (tid & 3) * 4;
  const long arow = gidx ? (long)gidx[m0 + ar] : (long)(m0 + ar);
  const AT* ap = A + arow * lda + ak;
  const int bk = tid >> 4, bn = (tid & 15) * 4;
  const float* bp = Bm + (long)bk * ldb + n0 + bn;
  for (int k0 = 0; k0 < K; k0 += 16) {
    const float4 av = ld_a4(ap + k0);
    const float4 bv = *(const float4*)(bp + (long)k0 * ldb);
    As[ak + 0][ar] = av.x; As[ak + 1][ar] = av.y; As[ak + 2][ar] = av.z; As[ak + 3][ar] = av.w;
    *(float4*)&Bs[bk][bn] = bv;
    __syncthreads();
#pragma unroll
    for (int kk = 0; kk < 16; ++kk) {
      const float4 a = *(const float4*)&As[kk][ty * 4]; const float4 b = *(const float4*)&Bs[kk][tx * 4];
      const float aa[4] = {a.x, a.y, a.z, a.w}; const float bb[4] = {b.x, b.y, b.z, b.w};
#pragma unroll
      for (int i = 0; i < 4; ++i)
#pragma unroll
        for (int j = 0; j < 4; ++j) acc[i][j] += aa[i] * bb[j];
    }
    __syncthreads();
  }
#pragma unroll
  for (int i = 0; i < 4; ++i)
#pragma unroll
    for (int j = 0; j < 4; ++j) epi(z, m0 + ty * 4 + i, n0 + tx * 4 + j, acc[i][j]);
}
__global__ void k_ctx_state2(const bf16* KC, const bf16* VC, const float* decf, const float* decb, float* S0) {
  int idx = blockIdx.x * blockDim.x + threadIdx.x;
  int v = idx & 255, d = (idx >> 8) & 127, h = (idx >> 15) & 3, b = (idx >> 17) & 1, dir = idx >> 18;
  if (dir >= 2) return;
  float dec = dir == 0 ? decf[h] : decb[h]; float lg = -log1pf(expf(-dec));
  float acc = 0.f;
  for (int t = 0; t < CTXL; ++t) {
    float w = expf((dir == 0 ? (float)(CTXL - 1 - t) : (float)t) * lg);
    acc += w * bf2f(KC[(size_t)(b * CTXL + t) * 512 + h * 128 + d]) * bf2f(VC[(size_t)(b * CTXL + t) * 1024 + h * 256 + v]);
  }
  S0[idx] = acc;
}
__global__ __launch_bounds__(256) void k_ret_rec2(const bf16* Q, const bf16* K, const bf16* V, const float* S0, const float* decf, const float* decb, float* OF, float* OB, int b, int pad) {
  __shared__ float qs[32][128]; __shared__ float ks[32][128];
  int h = blockIdx.x & 3, dir = blockIdx.x >> 2; int j = threadIdx.x;
  float dec = dir == 0 ? decf[h] : decb[h]; float gamma = 1.f / (1.f + expf(-dec));
  float S[128];
  const float* s0 = S0 + ((size_t)((dir * 2 + b) * 4 + h) * 128) * 256;
#pragma unroll
  for (int d = 0; d < 128; ++d) S[d] = s0[d * 256 + j];
  float* O = dir == 0 ? OF : OB;
  const size_t rb = (size_t)b * T;
  for (int blk = 0; blk < T / 32; ++blk) {
    int tb = dir == 0 ? blk * 32 : T - 32 - blk * 32;
    __syncthreads();
    for (int i = threadIdx.x; i < 32 * 128; i += 256) { int tt = i >> 7, d = i & 127; qs[tt][d] = bf2f(Q[(rb + tb + tt) * 512 + h * 128 + d]); ks[tt][d] = bf2f(K[(rb + tb + tt) * 512 + h * 128 + d]); }
    __syncthreads();
    for (int s = 0; s < 32; ++s) {
      int tt = dir == 0 ? s : 31 - s; int t = tb + tt;
      float vj = bf2f(V[(rb + t) * 1024 + h * 256 + j]);
      float o = 0.f;
#pragma unroll
      for (int d = 0; d < 128; ++d) { S[d] = gamma * S[d] + ks[tt][d] * vj; o += qs[tt][d] * S[d]; }
      O[(size_t)t * D + h * 256 + j] = o;
    }
  }
}
__global__ void k_ret_fin2(const float* OF, const float* OB, const bf16* SGb, const float* gw, const float* gb, float* RET) {
  int w = (blockIdx.x * blockDim.x + threadIdx.x) >> 6; int lane = threadIdx.x & 63;
  if (w >= T * 4) return; int t = w >> 2, h = w & 3;
  float v[4]; float s = 0.f;
#pragma unroll
  for (int i = 0; i < 4; ++i) { int cidx = h * 256 + lane + 64 * i; v[i] = OF[(size_t)t * D + cidx] + OB[(size_t)t * D + cidx]; s += v[i]; }
  float mean = wave_sum(s) * (1.f / 256); float q = 0.f;
#pragma unroll
  for (int i = 0; i < 4; ++i) { v[i] -= mean; q += v[i] * v[i]; }
  float rstd = rsqrtf(wave_sum(q) * (1.f / 256) + LN_EPS);
#pragma unroll
  for (int i = 0; i < 4; ++i) { int cidx = h * 256 + lane + 64 * i; float y = v[i] * rstd * gw[cidx] + gb[cidx]; RET[(size_t)t * D + cidx] = y * bf2f(SGb[(size_t)t * D + cidx]); }
}
__global__ void k_gv2(const bf16* GVSb, const float* lw, const float* lb, float* GV) {
  int row = (blockIdx.x * blockDim.x + threadIdx.x) >> 6; int lane = threadIdx.x & 63;
  if (row >= T) return;
  float v[16]; float s = 0.f;
#pragma unroll
  for (int i = 0; i < 16; ++i) { v[i] = bf2f(GVSb[(size_t)row * D + lane + 64 * i]); s += v[i]; }
  float mean = wave_sum(s) * (1.f / D); float q = 0.f;
#pragma unroll
  for (int i = 0; i < 16; ++i) { v[i] -= mean; q += v[i] * v[i]; }
  float rstd = rsqrtf(wave_sum(q) * (1.f / D) + LN_EPS);
#pragma unroll
  for (int i = 0; i < 16; ++i) { int cidx = lane + 64 * i; GV[(size_t)row * D + cidx] = v[i] * rstd * lw[cidx] + lb[cidx]; }
}
__global__ void k_sgu2(const bf16* GUb, const float* GV, const float* sw, const float* sb, float* SGU) {
  int idx = blockIdx.x * blockDim.x + threadIdx.x; int ch = idx & 1023, t = idx >> 10;
  if (t >= T) return; int n = t >> 7, p = t & 127, g = ch >> 8;
  const float* wrow = sw + ((size_t)g * 128 + p) * 128; float acc = 0.f;
  for (int q = 0; q < 128; ++q) acc += wrow[q] * GV[(size_t)(n * 128 + q) * D + ch];
  acc += sb[g * 128 + p];
  SGU[(size_t)t * D + ch] = bf2f(GUb[(size_t)t * D + ch]) * acc;
}
__global__ void k_router(const float* H2, const float* wr, const float* br, float* AFF) {
  int row = (blockIdx.x * blockDim.x + threadIdx.x) >> 6; int lane = threadIdx.x & 63;
  if (row >= T) return;
  float acc[NE];
#pragma unroll
  for (int e = 0; e < NE; ++e) acc[e] = 0.f;
  for (int i = 0; i < 16; ++i) { int k = lane + 64 * i; float hv = H2[(size_t)row * D + k];
#pragma unroll
    for (int e = 0; e < NE; ++e) acc[e] += hv * wr[k * NE + e]; }
  float mx = -1e30f;
#pragma unroll
  for (int e = 0; e < NE; ++e) { acc[e] = wave_sum(acc[e]) + br[e]; mx = fmaxf(mx, acc[e]); }
  float sum = 0.f;
#pragma unroll
  for (int e = 0; e < NE; ++e) { acc[e] = expf(acc[e] - mx); sum += acc[e]; }
  if (lane < NE) { float o = 0.f;
#pragma unroll
    for (int e = 0; e < NE; ++e) if (e == lane) o = acc[e];
    AFF[(size_t)row * NE + lane] = o / sum; }
}
__global__ void k_topk(const float* AFF, int* IDX, float* GATE) {
  int idx = blockIdx.x * blockDim.x + threadIdx.x; int t = idx & (T - 1), e = idx >> 13;
  if (e >= NE) return;
  float a = AFF[(size_t)t * NE + e]; int rank = 0;
  for (int s = 0; s < T; ++s) { float o = AFF[(size_t)s * NE + e]; rank += (o > a) || (o == a && s < t); }
  if (rank < CAP) { IDX[e * CAP + rank] = t; GATE[e * CAP + rank] = a; }
}
__global__ void k_hidden(float* G1, const float* U1, size_t n) { size_t i = (size_t)blockIdx.x * blockDim.x + threadIdx.x; if (i < n) G1[i] = siluf_(G1[i]) * U1[i]; }
__global__ void k_zero(float* p, size_t n) { size_t i = (size_t)blockIdx.x * blockDim.x + threadIdx.x; if (i < n) p[i] = 0.f; }
__global__ void k_scatter(const float* YE, const int* IDX, const float* GATE, float* MOE) {
  size_t i = (size_t)blockIdx.x * blockDim.x + threadIdx.x; if (i >= (size_t)NE * CAP * D) return;
  int d = i & 1023; int es = i >> 10; atomicAdd(&MOE[(size_t)IDX[es] * D + d], YE[i] * GATE[es]);
}
}

extern "C" void kernel_launch(void* const* d_in, const int* in_sizes, int n_in, void* d_out, int out_size, void* d_ws, size_t ws_size, hipStream_t stream) {
  static int grid = 0;
  if (grid == 0) {
    if (n_in != 29 || out_size != M * D || ws_size < WS_END) { fprintf(stderr, "kernel_launch: unexpected shapes / workspace (%d inputs, out %d, ws %zu)\n", n_in, out_size, ws_size); grid = -1; return; }
    int dev = 0, cus = 0, per_cu = 0;
    if (hipGetDevice(&dev) != hipSuccess || hipDeviceGetAttribute(&cus, hipDeviceAttributeMultiprocessorCount, dev) != hipSuccess) { grid = -1; return; }
    if (hipFuncSetAttribute((const void*)mk_fwd, hipFuncAttributeMaxDynamicSharedMemorySize, LDS_BYTES) != hipSuccess) { fprintf(stderr, "kernel_launch: hipFuncSetAttribute failed\n"); grid = -1; return; }
    if (hipOccupancyMaxActiveBlocksPerMultiprocessor(&per_cu, (const void*)mk_fwd, NWAVES * 64, LDS_BYTES) != hipSuccess || per_cu < 1) fprintf(stderr, "kernel_launch: occupancy query says %d\n", per_cu);
    (void)hipGetLastError();
    grid = cus;
  }
  if (grid < 0) return;
  using namespace nv;
  if (hipMemsetAsync((char*)d_ws + WS_CTL, 0, CTL_ZERO_BYTES, stream) != hipSuccess) return;
  Args a{};
  for (int i = 0; i < 29; ++i) a.in[i] = (const float*)d_in[i];
  a.out = (float*)d_out; a.ws = (unsigned char*)d_ws; a.ph_lo = 0; a.ph_hi = 13; a.li = 0; a.pad = 0;
  hipLaunchKernelGGL(mk_fwd, dim3(grid), dim3(NWAVES * 64), LDS_BYTES, stream, a);

}
```

```cpp
#include <hip/hip_runtime.h>
#include <cstdio>
#include <cstdint>

namespace pg8 {
#define PG8_LAS __attribute__((address_space(3)))
typedef unsigned short bf16_t;
typedef short bf16x8 __attribute__((ext_vector_type(8)));
typedef float f32x4 __attribute__((ext_vector_type(4)));
typedef unsigned u32x4 __attribute__((ext_vector_type(4)));
constexpr int BM = 256, BK = 64, HALF = 128, HTB = HALF * BK * 2  , STAGE_BYTES = 8 * HTB, NXCD = 8, WGM = 8;

__host__ __device__ __forceinline__ int lds_byte(int r, int c) { const int st = (r >> 4) * 2 + (c >> 5), rr = r & 15, cc = c & 31, ob = rr * 64 + cc * 2; return st * 1024 + (ob ^ (((ob >> 9) & 1) << 5)); }
__host__ __device__ __forceinline__ void stage_rc(int b, int& R, int& C) { const int st = b / 1024, sb = b % 1024, swz = sb ^ (((sb >> 9) & 1) << 5); R = (st >> 1) * 16 + swz / 64; C = (st & 1) * 32 + (swz % 64) / 2; }
__host__ __device__ __forceinline__ int perm32(int rho) { const int n = rho >> 4, i = rho & 15; return 8 * (i >> 2) + 4 * n + (i & 3); }

struct Unit { int pm, pn; };
struct Gemm { const bf16_t* A; const bf16_t* Bt; int M, N, K; };

struct StaticOrder {
    int nM, nN, nwg, G, c;
    __host__ __device__ void init(int M, int N, int G_, int c_) { nM = M / BM; nN = N / BM; nwg = nM * nN; G = G_; c = c_; }
    __host__ __device__ bool next(int i, Unit& u) const {
        const long L = (long)i * G + c; if (L >= nwg) return false;
        int wgid = (int)L; { const int q = nwg / NXCD, r = nwg % NXCD, xcd = wgid % NXCD, off = wgid / NXCD; wgid = (xcd < r ? xcd * (q + 1) : r * (q + 1) + (xcd - r) * q) + off; }
        const int nig = WGM * nN, gid = wgid / nig, fm = gid * WGM, gsz = (nM - fm) < WGM ? (nM - fm) : WGM;
        u.pm = fm + ((wgid % nig) % gsz); u.pn = (wgid % nig) / gsz; return true;
    }
    __device__ __forceinline__ void a_ready(const Unit&) const {}
    __device__ __forceinline__ void done(const Unit&) const {}
};

typedef float f32x2c __attribute__((ext_vector_type(2)));
typedef __bf16 bf16x2c __attribute__((ext_vector_type(2)));
__device__ __forceinline__ unsigned cvt_pk_bf16(float lo, float hi) { const f32x2c v = {lo, hi}; return __builtin_bit_cast(unsigned, __builtin_convertvector(v, bf16x2c)); }
__device__ __forceinline__ unsigned cvt_pk2(f32x2c v) { return __builtin_bit_cast(unsigned, __builtin_convertvector(v, bf16x2c)); }

struct XUnit { int pm, pn; const char* A; const char* B; int flags; int pad; };
constexpr size_t TS1K = (size_t)256 * 1024 * 2;
constexpr float KSCALE_F = 0.08838834764831845f;
__device__ __forceinline__ float fsig(float x) { return __builtin_amdgcn_rcpf(1.f + __expf(-x)); }
__device__ __forceinline__ float fsilu(float x) { return x * fsig(x); }
__device__ __forceinline__ float fgelu(float x) { return x * fsig(1.5957691216057308f * x * (1.f + 0.044715f * x * x)); }
__device__ __forceinline__ float fact(float x, int act) { return act == 0 ? x : (act == 1 ? fsilu(x) : (act == 2 ? fgelu(x) : fsig(x))); }

struct EpiZ {
    static constexpr bool PERM = true, AFTER_DRAIN = false;
    bf16_t *Q, *V, *KC, *VC; const float* bias; const float* tab; float* vstat;
    __device__ __forceinline__ void transform(f32x4 (&)[2][2][4][2], const XUnit&, int, int, int, int) const {}
    __device__ __forceinline__ void operator()(const f32x4 (&acc)[2][2][4][2], const XUnit& u, int wr, int wc, int fr, int fq) const {
        const int pn = u.pn; const bool isctx = u.pm >= 64;
        const int rowbase = (isctx ? (u.pm - 64) : u.pm) * 256 + wr * 64 + fr;
        if (pn < 4) {
            const bool isk = pn >= 2; const int tile = pn & 1;
            bf16_t* dst = isctx ? KC : Q + (isk ? (size_t)8 * 1048576 : (size_t)0);
            const float scale = isk ? KSCALE_F : 1.f;
            const int lc = 256 * tile + 64 * wc + 8 * fq;
            const int a = wc & 1;
            const float* bp = bias + (isk ? 512 : 0) + lc;
            f32x4 b1[2], b2[2];
#pragma unroll
            for (int n = 0; n < 2; ++n) { b1[n] = *(const f32x4*)(bp + 4 * n); b2[n] = *(const f32x4*)(bp + 32 + 4 * n); }
            f32x4 tt[4], tn[4];
            { const int t = rowbase & 8191; const int pos = a ? (t & 63) : (t >> 6); const float* tp = tab + (pos * 32 + 8 * fq) * 2;
#pragma unroll
              for (int j = 0; j < 4; ++j) tt[j] = isctx ? (f32x4){1.f, 0.f, 1.f, 0.f} : *(const f32x4*)(tp + 4 * j); }
#pragma unroll
            for (int it = 0; it < 8; ++it) {
                    const int ai = it >> 2, m = it & 3;
                    const int row = rowbase + ai * 128 + m * 16;
                    if (it < 7) { const int rown = rowbase + ((it + 1) >> 2) * 128 + ((it + 1) & 3) * 16; const int t = rown & 8191; const int pos = a ? (t & 63) : (t >> 6); const float* tp = tab + (pos * 32 + 8 * fq) * 2;
#pragma unroll
                        for (int j = 0; j < 4; ++j) tn[j] = isctx ? (f32x4){1.f, 0.f, 1.f, 0.f} : *(const f32x4*)(tp + 4 * j); }
                    float o1[8], o2[8];
#pragma unroll
                    for (int j = 0; j < 8; ++j) { const float x1 = acc[ai][0][m][j >> 2][j & 3] + b1[j >> 2][j & 3], x2 = acc[ai][1][m][j >> 2][j & 3] + b2[j >> 2][j & 3];
                        const float cs = tt[j >> 1][(j & 1) * 2], sn = tt[j >> 1][(j & 1) * 2 + 1];
                        o1[j] = (x1 * cs - x2 * sn) * scale; o2[j] = (x2 * cs + x1 * sn) * scale; }
                    u32x4 w1, w2;
                    w1.x = cvt_pk_bf16(o1[0], o1[1]); w1.y = cvt_pk_bf16(o1[2], o1[3]); w1.z = cvt_pk_bf16(o1[4], o1[5]); w1.w = cvt_pk_bf16(o1[6], o1[7]);
                    w2.x = cvt_pk_bf16(o2[0], o2[1]); w2.y = cvt_pk_bf16(o2[2], o2[3]); w2.z = cvt_pk_bf16(o2[4], o2[5]); w2.w = cvt_pk_bf16(o2[6], o2[7]);
                    { const int head = 2 * tile + (wc >> 1), db1 = (wc & 1) * 8 + fq;
                      const size_t tb = isctx ? ((size_t)(((row >> 8) * 4 + head) * 2 + ((row >> 7) & 1)) * 16) : ((size_t)(((row >> 13) * 4 + head) * 64 + ((row & 8191) >> 7)) * 16);
                      bf16_t* rp = dst + ((tb + db1) * 128 + (row & 127)) * 8;
                      __builtin_nontemporal_store(w1, (u32x4*)rp); __builtin_nontemporal_store(w2, (u32x4*)(rp + 4 * 128 * 8)); }
#pragma unroll
                    for (int j = 0; j < 4; ++j) tt[j] = tn[j];
                }
        } else {
            switch ((pn - 4) >> 2) {
                case 0: sect<0>(acc, pn, isctx, rowbase, wc, fq); break;
                case 1: sect<1>(acc, pn, isctx, rowbase, wc, fq); break;
                case 2: sect<2>(acc, pn, isctx, rowbase, wc, fq); break;
                case 3: sect<3>(acc, pn, isctx, rowbase, wc, fq); break;
                case 4: sect<4>(acc, pn, isctx, rowbase, wc, fq); break;
                default: sect<5>(acc, pn, isctx, rowbase, wc, fq); break;
            }
        }
    }
    template <int ACT> static __device__ __forceinline__ void act8(f32x2c (&o)[4]) {
        if constexpr (ACT != 0) {
            f32x2c e[4];
#pragma unroll
            for (int j = 0; j < 4; ++j) {
                if constexpr (ACT == 2) e[j] = o[j] * __builtin_elementwise_fma(o[j] * o[j], (f32x2c)(-1.442695041f * 1.5957691216057308f * 0.044715f), (f32x2c)(-1.442695041f * 1.5957691216057308f));
                else e[j] = o[j] * -1.442695041f; }
#pragma unroll
            for (int j = 0; j < 4; ++j) { e[j].x = __builtin_amdgcn_exp2f(e[j].x); e[j].y = __builtin_amdgcn_exp2f(e[j].y); }
#pragma unroll
            for (int j = 0; j < 4; ++j) { e[j] = e[j] + 1.f; e[j].x = __builtin_amdgcn_rcpf(e[j].x); e[j].y = __builtin_amdgcn_rcpf(e[j].y); }
#pragma unroll
            for (int j = 0; j < 4; ++j) o[j] = ACT == 3 ? e[j] : o[j] * e[j];
        }
    }
    template <int S> __device__ __forceinline__ void sect(const f32x4 (&acc)[2][2][4][2], int pn, bool isctx, int rowbase, int wc, int fq) const {
            constexpr int ACT = S == 0 ? 0 : (S + 2) >> 1;
            bf16_t* dst = (S == 0 && isctx) ? VC : V + (size_t)S * 16 * 1048576;
            const int col0 = 256 * ((pn - 4) & 3) + 32 * wc + 8 * fq;
            const float* bp = bias + 256 * pn + 32 * wc + 8 * fq;
            f32x4 bv[2][2];
#pragma unroll
            for (int bj = 0; bj < 2; ++bj)
#pragma unroll
                for (int n = 0; n < 2; ++n) bv[bj][n] = *(const f32x4*)(bp + bj * 128 + 4 * n);
#pragma unroll
            for (int ai = 0; ai < 2; ++ai)
#pragma unroll
                for (int m = 0; m < 4; ++m) {
                    const int row = rowbase + ai * 128 + m * 16;
                    bf16_t* rp = dst + (size_t)row * 1024 + col0;
                    size_t gstep = 128;
                    if constexpr (S == 0) { const size_t tb = isctx ? ((size_t)(((row >> 8) * 4 + ((pn - 4) & 3)) * 2 + ((row >> 7) & 1)) * 32) : ((size_t)(((row >> 13) * 4 + ((pn - 4) & 3)) * 64 + ((row & 8191) >> 7)) * 32);
                        rp = dst + ((tb + 4 * wc + fq) * 128 + (row & 127)) * 8; gstep = (size_t)16 * 128 * 8; }
                    if constexpr (S == 3) { const size_t tb = (size_t)((((row >> 13) * 64 + ((row & 8191) >> 7)) * 4 + (pn - 16)) * 32);
                        rp = dst + ((tb + 4 * wc + fq) * 128 + (row & 127)) * 8; gstep = (size_t)16 * 128 * 8; }
                    f32x2c ssum2 = {0.f, 0.f}, ssq2 = {0.f, 0.f};
#pragma unroll
                    for (int bj = 0; bj < 2; ++bj) {
                        f32x2c o[4];
#pragma unroll
                        for (int j = 0; j < 4; ++j) { const f32x4 t = acc[ai][bj][m][j >> 1] + bv[bj][j >> 1]; o[j] = (j & 1) ? (f32x2c){t[2], t[3]} : (f32x2c){t[0], t[1]}; }
                        act8<ACT>(o);
                        if constexpr (S == 3) {
#pragma unroll
                            for (int j = 0; j < 4; ++j) { ssum2 += o[j]; ssq2 = __builtin_elementwise_fma(o[j], o[j], ssq2); } }
                        u32x4 w; w.x = cvt_pk2(o[0]); w.y = cvt_pk2(o[1]); w.z = cvt_pk2(o[2]); w.w = cvt_pk2(o[3]);
                        __builtin_nontemporal_store(w, (u32x4*)(rp + bj * gstep));
                    }
                    if constexpr (S == 3) {
                        float ssum = ssum2.x + ssum2.y, ssq = ssq2.x + ssq2.y;
                        ssum += __shfl_xor(ssum, 16); ssum += __shfl_xor(ssum, 32); ssq += __shfl_xor(ssq, 16); ssq += __shfl_xor(ssq, 32);
                        if (fq == 0) { float* sp = vstat + ((size_t)row * 16 + (pn - 16) * 4 + wc) * 2; sp[0] = ssum; sp[1] = ssq; } }
                }
    }
};
__device__ __forceinline__ void plain_offs(int tid, int K, unsigned (&o0)[2], unsigned (&o1)[2]) {
#pragma unroll
    for (int i = 0; i < 2; ++i) { int R, C; stage_rc(tid * 16 + i * 8192, R, C); o0[i] = (unsigned)(R * K + C) * 2u; o1[i] = o0[i] + (unsigned)(HALF * K * 2); }
}
constexpr int NG2 = 232, CF0 = 168;
struct SchedP2 {
    StaticOrder so; int G, c; const char* A; const char* B; bool front; unsigned* flag;
    __device__ void init(int G_, int c_, const void* A_, const void* B_, unsigned* flag_, bool front_) { so.init(16384, 7168, G_, c_); G = G_; c = c_; A = (const char*)A_; B = (const char*)B_; front = front_; flag = flag_; }
    __device__ bool next(int i, XUnit& u) const {
        Unit t;
        if (front) { const bool cx = c >= CF0 && c < CF0 + 12; if (cx && i == 0) { t.pm = 64 + (c - CF0) / 6; t.pn = 2 + (c - CF0) % 6; } else if (!so.next(cx ? i - 1 : i, t)) return false; }
        else if (!so.next(i, t)) { const long L = (long)i * G + c - 1792; if (L < 0 || L >= 12) return false; t.pm = 64 + (int)(L / 6); t.pn = 2 + (int)(L % 6); }
        u.pm = t.pm; u.pn = t.pn; u.A = A + (size_t)t.pm * TS1K; u.B = B + (size_t)t.pn * TS1K; u.flags = 3; return true;
    }
    __device__ __forceinline__ void a_ready(const XUnit&) const {}
    __device__ __forceinline__ void after_unit(const XUnit& u, int tid) const {
        if (front && u.pm >= 64) {
            asm volatile("s_waitcnt vmcnt(0)" ::: "memory");
            __builtin_amdgcn_s_barrier();
            if (tid == 0) { __builtin_amdgcn_fence(__ATOMIC_RELEASE, "agent"); asm volatile("s_waitcnt vmcnt(0)" ::: "memory"); __hip_atomic_fetch_add(flag, 1u, __ATOMIC_RELAXED, __HIP_MEMORY_SCOPE_AGENT); }
        }
    }
    __device__ __forceinline__ void offs(const XUnit&, int tid, int K, unsigned (&o0)[2], unsigned (&o1)[2]) const { plain_offs(tid, K, o0, o1); }
};
struct SchedN {
    StaticOrder so; const char* A; const char* B;
    __device__ void init(int M_, int N_, int G_, int c_, const void* A_, const void* B_) { so.init(M_, N_, G_, c_); A = (const char*)A_; B = (const char*)B_; }
    __device__ bool next(int i, XUnit& u) const { Unit t; if (!so.next(i, t)) return false; u.pm = t.pm; u.pn = t.pn; u.A = A + (size_t)t.pm * TS1K; u.B = B + (size_t)t.pn * TS1K; u.flags = 3; return true; }
    __device__ __forceinline__ void a_ready(const XUnit&) const {}
    __device__ __forceinline__ void after_unit(const XUnit&, int) const {}
    __device__ __forceinline__ void offs(const XUnit&, int tid, int K, unsigned (&o0)[2], unsigned (&o1)[2]) const { plain_offs(tid, K, o0, o1); }
};
struct SchedY {
    StaticOrder so; const char *A1, *B1, *A2, *B2;
    __device__ void init(int M_, int N_, int G_, int c_, const void* a1, const void* b1, const void* a2, const void* b2) { so.init(M_, N_, G_, c_); A1 = (const char*)a1; B1 = (const char*)b1; A2 = (const char*)a2; B2 = (const char*)b2; }
    __device__ bool next(int i, XUnit& u) const { Unit t; if (!so.next(i >> 1, t)) return false; u.pm = t.pm; u.pn = t.pn;
        if ((i & 1) == 0) { u.A = A1 + (size_t)t.pm * TS1K; u.B = B1 + (size_t)t.pn * TS1K; u.flags = 1 | 4; } else { u.A = A2 + (size_t)t.pm * TS1K; u.B = B2 + (size_t)t.pn * TS1K; u.flags = 2; } return true; }
    __device__ __forceinline__ void a_ready(const XUnit&) const {}
    __device__ __forceinline__ void after_unit(const XUnit&, int) const {}
    __device__ __forceinline__ void offs(const XUnit&, int tid, int K, unsigned (&o0)[2], unsigned (&o1)[2]) const { plain_offs(tid, K, o0, o1); }
};
__device__ __forceinline__ void unpack8(const u32x4& w, float (&f)[8]) {
#pragma unroll
    for (int j = 0; j < 4; ++j) { f[2 * j] = __builtin_bit_cast(float, w[j] << 16); f[2 * j + 1] = __builtin_bit_cast(float, w[j] & 0xffff0000u); }
}
struct EpiY {
    static constexpr bool PERM = true;
    const bf16_t* SGA; const bf16_t* SGB; bf16_t* Y;
    __device__ __forceinline__ void transform(f32x4 (&acc)[2][2][4][2], const XUnit& u, int wr, int wc, int fr, int fq) const {
        const int row0 = u.pm * BM + wr * 64 + fr, col0 = u.pn * BM + wc * 32 + 8 * fq;
        u32x4 ra[3][2], rb[3][2];
#pragma unroll
        for (int it = 0; it < 3; ++it) { const size_t o = (size_t)(row0 + (it >> 2) * HALF + (it & 3) * 16) * 1024 + col0;
            ra[it][0] = *(const u32x4*)(SGA + o); ra[it][1] = *(const u32x4*)(SGA + o + HALF); rb[it][0] = *(const u32x4*)(SGB + o); rb[it][1] = *(const u32x4*)(SGB + o + HALF); }
#pragma unroll
        for (int it = 0; it < 8; ++it) { const int ai = it >> 2, m = it & 3, sl = it % 3;
#pragma unroll
            for (int bj = 0; bj < 2; ++bj) { float a[8], b[8]; unpack8(ra[sl][bj], a); unpack8(rb[sl][bj], b);
#pragma unroll
                for (int j = 0; j < 8; ++j) acc[ai][bj][m][j >> 2][j & 3] *= a[j] * __builtin_amdgcn_rcpf(fmaxf(b[j], 1e-30f)); }
            if (it + 3 < 8) { const size_t o = (size_t)(row0 + ((it + 3) >> 2) * HALF + ((it + 3) & 3) * 16) * 1024 + col0;
                ra[sl][0] = *(const u32x4*)(SGA + o); ra[sl][1] = *(const u32x4*)(SGA + o + HALF); rb[sl][0] = *(const u32x4*)(SGB + o); rb[sl][1] = *(const u32x4*)(SGB + o + HALF); } }
    }
    __device__ __forceinline__ void operator()(const f32x4 (&acc)[2][2][4][2], const XUnit& u, int wr, int wc, int fr, int fq) const {
        const int row0 = u.pm * BM + wr * 64 + fr, col0 = u.pn * BM + wc * 32 + 8 * fq;
        u32x4 rb[4][2];
#pragma unroll
        for (int it = 0; it < 4; ++it) { const size_t o = (size_t)(row0 + (it >> 2) * HALF + (it & 3) * 16) * 1024 + col0; rb[it][0] = *(const u32x4*)(SGB + o); rb[it][1] = *(const u32x4*)(SGB + o + HALF); }
#pragma unroll
        for (int it = 0; it < 8; ++it) { const int ai = it >> 2, m = it & 3, sl = it & 3; const size_t o = (size_t)(row0 + ai * HALF + m * 16) * 1024 + col0;
            u32x4 w[2];
#pragma unroll
            for (int bj = 0; bj < 2; ++bj) { float b[8]; unpack8(rb[sl][bj], b); float y[8];
#pragma unroll
                for (int j = 0; j < 8; ++j) y[j] = acc[ai][bj][m][j >> 2][j & 3] * fmaxf(b[j], 1e-30f);
                w[bj].x = cvt_pk_bf16(y[0], y[1]); w[bj].y = cvt_pk_bf16(y[2], y[3]); w[bj].z = cvt_pk_bf16(y[4], y[5]); w[bj].w = cvt_pk_bf16(y[6], y[7]); }
            if (it + 4 < 8) { const size_t on = (size_t)(row0 + ((it + 4) >> 2) * HALF + ((it + 4) & 3) * 16) * 1024 + col0; rb[sl][0] = *(const u32x4*)(SGB + on); rb[sl][1] = *(const u32x4*)(SGB + on + HALF); }
            *(u32x4*)(Y + o) = w[0]; *(u32x4*)(Y + o + HALF) = w[1]; }
    }
};
struct EpiMix {
    static constexpr bool PERM = false;
    const float* x; const float* mod; const float* bo; float* out;
    __device__ __forceinline__ void transform(f32x4 (&)[2][2][4][2], const XUnit&, int, int, int, int) const {}
    __device__ __forceinline__ void operator()(const f32x4 (&acc)[2][2][4][2], const XUnit& u, int wr, int wc, int fr, int fq) const {
        const int row0 = u.pm * BM + wr * 64 + fr, col0 = u.pn * BM + wc * 32 + 4 * fq;
        const float* g1 = mod + (u.pm >= 32 ? 6144 : 0) + 2048;
        f32x4 bv[2][2], gv[2][2];
#pragma unroll
        for (int bj = 0; bj < 2; ++bj)
#pragma unroll
            for (int n = 0; n < 2; ++n) { bv[bj][n] = *(const f32x4*)(bo + col0 + bj * HALF + n * 16); gv[bj][n] = *(const f32x4*)(g1 + col0 + bj * HALF + n * 16); }
        f32x4 rx[3][2][2];
#pragma unroll
        for (int it = 0; it < 3; ++it) { const size_t o = (size_t)(row0 + (it >> 2) * HALF + (it & 3) * 16) * 1024 + col0;
#pragma unroll
          for (int bj = 0; bj < 2; ++bj)
#pragma unroll
              for (int n = 0; n < 2; ++n) rx[it][bj][n] = *(const f32x4*)(x + o + bj * HALF + n * 16); }
#pragma unroll
        for (int it = 0; it < 8; ++it) { const int ai = it >> 2, m = it & 3, sl = it % 3; const size_t o = (size_t)(row0 + ai * HALF + m * 16) * 1024 + col0;
            f32x4 r[2][2];
#pragma unroll
            for (int bj = 0; bj < 2; ++bj)
#pragma unroll
                for (int n = 0; n < 2; ++n) r[bj][n] = rx[sl][bj][n] * 1.189207115002721f + gv[bj][n] * (acc[ai][bj][m][n] + bv[bj][n]);
            if (it + 3 < 8) { const size_t on = (size_t)(row0 + ((it + 3) >> 2) * HALF + ((it + 3) & 3) * 16) * 1024 + col0;
#pragma unroll
                for (int bj = 0; bj < 2; ++bj)
#pragma unroll
                    for (int n = 0; n < 2; ++n) rx[sl][bj][n] = *(const f32x4*)(x + on + bj * HALF + n * 16); }
#pragma unroll
            for (int bj = 0; bj < 2; ++bj)
#pragma unroll
                for (int n = 0; n < 2; ++n) *(f32x4*)(out + o + bj * HALF + n * 16) = r[bj][n]; }
    }
};

struct SchedG1 {
    int G, c; const char* H2; const char* W; const int* idx;
    __device__ void init(int G_, int c_, const void* h2, const void* w, const int* idx_) { G = G_; c = c_; H2 = (const char*)h2; W = (const char*)w; idx = idx_; }
    __device__ bool next(int i, XUnit& u) const { const long L = (long)i * G + c; if (L >= 1024) return false;
        const int g = (int)(L >> 5), r = (int)(L & 31); u.pm = g * 4 + (r & 3); u.pn = r >> 2;
        u.A = H2 + (size_t)(g >> 4) * 8192 * 2048; u.B = W + ((size_t)(g & 15) * 2048 + (size_t)u.pn * 256) * 2048; u.flags = 3; return true; }
    __device__ __forceinline__ void a_ready(const XUnit&) const {}
    __device__ __forceinline__ void after_unit(const XUnit&, int) const {}
    __device__ __forceinline__ void offs(const XUnit& u, int tid, int K, unsigned (&o0)[2], unsigned (&o1)[2]) const {
#pragma unroll
        for (int i = 0; i < 2; ++i) { int R, C; stage_rc(tid * 16 + i * 8192, R, C);
            const int t0 = idx[u.pm * 256 + R], t1 = idx[u.pm * 256 + 128 + R];
            o0[i] = (unsigned)(t0 * K + C) * 2u; o1[i] = (unsigned)(t1 * K + C) * 2u; }
    }
};
struct EpiH {
    static constexpr bool PERM = true;
    bf16_t* HID;
    __device__ __forceinline__ void transform(f32x4 (&)[2][2][4][2], const XUnit&, int, int, int, int) const {}
    __device__ __forceinline__ void operator()(const f32x4 (&acc)[2][2][4][2], const XUnit& u, int wr, int wc, int fr, int fq) const {
        const int row0 = u.pm * BM + wr * 64 + fr, col0 = u.pn * 128 + wc * 32 + 8 * fq;
#pragma unroll
        for (int ai = 0; ai < 2; ++ai)
#pragma unroll
            for (int m = 0; m < 4; ++m) { float h[8];
#pragma unroll
                for (int j = 0; j < 8; ++j) { const float gt = acc[ai][0][m][j >> 2][j & 3], up = acc[ai][1][m][j >> 2][j & 3]; h[j] = fsilu(gt) * up; }
                u32x4 w; w.x = cvt_pk_bf16(h[0], h[1]); w.y = cvt_pk_bf16(h[2], h[3]); w.z = cvt_pk_bf16(h[4], h[5]); w.w = cvt_pk_bf16(h[6], h[7]);
                *(u32x4*)(HID + (size_t)(row0 + ai * HALF + m * 16) * 1024 + col0) = w; }
    }
};
struct SchedG2 {
    int G, c; const char* HID; const char* W;
    __device__ void init(int G_, int c_, const void* hid, const void* w) { G = G_; c = c_; HID = (const char*)hid; W = (const char*)w; }
    __device__ bool next(int i, XUnit& u) const { const long L = (long)i * G + c; if (L >= 512) return false;
        const int g = (int)(L >> 4), r = (int)(L & 15); u.pm = g * 4 + (r & 3); u.pn = r >> 2;
        u.A = HID + (size_t)u.pm * TS1K; u.B = W + ((size_t)(g & 15) * 1024 + (size_t)u.pn * 256) * 2048; u.flags = 3; return true; }
    __device__ __forceinline__ void a_ready(const XUnit&) const {}
    __device__ __forceinline__ void after_unit(const XUnit&, int) const {}
    __device__ __forceinline__ void offs(const XUnit&, int tid, int K, unsigned (&o0)[2], unsigned (&o1)[2]) const { plain_offs(tid, K, o0, o1); }
};
struct EpiYE {
    static constexpr bool PERM = true;
    bf16_t* YE; const float* gatew;
    __device__ __forceinline__ void transform(f32x4 (&)[2][2][4][2], const XUnit&, int, int, int, int) const {}
    __device__ __forceinline__ void operator()(const f32x4 (&acc)[2][2][4][2], const XUnit& u, int wr, int wc, int fr, int fq) const {
        const int row0 = u.pm * BM + wr * 64 + fr, col0 = u.pn * BM + wc * 32 + 8 * fq;
        float gts[8];
#pragma unroll
        for (int it = 0; it < 8; ++it) gts[it] = gatew[row0 + (it >> 2) * HALF + (it & 3) * 16];
#pragma unroll
        for (int ai = 0; ai < 2; ++ai)
#pragma unroll
            for (int m = 0; m < 4; ++m) { const int row = row0 + ai * HALF + m * 16; const float gt = gts[ai * 4 + m];
#pragma unroll
                for (int bj = 0; bj < 2; ++bj) { float y[8];
#pragma unroll
                    for (int j = 0; j < 8; ++j) y[j] = acc[ai][bj][m][j >> 2][j & 3] * gt;
                    u32x4 w; w.x = cvt_pk_bf16(y[0], y[1]); w.y = cvt_pk_bf16(y[2], y[3]); w.z = cvt_pk_bf16(y[4], y[5]); w.w = cvt_pk_bf16(y[6], y[7]);
                    *(u32x4*)(YE + (size_t)row * 1024 + col0 + bj * HALF) = w; } }
    }
};

template <class Epi, class Sched, bool ALIGN_EPI = false, bool SP2 = false>
__device__ __forceinline__ void gemm_phase(PG8_LAS unsigned char* lds, const int K, const Sched& S, const Epi& E) {
    const int tid = threadIdx.x, wid = __builtin_amdgcn_readfirstlane(tid >> 6), lane = tid & 63, wr = wid >> 2, wc = wid & 3, fr = lane & 15, fq = lane >> 4;
    const int nt = K / BK;
    unsigned voffA[2], voffB[2];
#pragma unroll
    for (int i = 0; i < 2; ++i) { int R, C; stage_rc(tid * 16 + i * 8192, R, C); const int Rb = Epi::PERM ? ((R & ~31) + perm32(R & 31)) : R;
        voffA[i] = (unsigned)(R * K + C) * 2u; voffB[i] = (unsigned)(Rb * K + C) * 2u; }
    unsigned oc0[2], oc1[2], on0[2], on1[2];
    const size_t kstep = (size_t)(BK * 2);
    const size_t hstep = (size_t)HALF * K * 2;
    const size_t tstep = 2 * hstep;
    const unsigned ldsw = (unsigned)wid * 1024u;
    const int aoff = lds_byte(wr * 64 + fr, fq * 8), boff = lds_byte(wc * 32 + fr, fq * 8);
#define PG8_SA(b, h) (((b) * 2 + (h)) * HTB)
#define PG8_SB(b, h) ((4 + (b) * 2 + (h)) * HTB)
#define PG8_STAGE(bufoff, gbase, voff) do { _Pragma("unroll") for (int _i = 0; _i < 2; ++_i) \
        __builtin_amdgcn_global_load_lds((const unsigned*)((const char*)(gbase) + (voff)[_i]), (PG8_LAS unsigned*)(lds + (bufoff) + ldsw + _i * 8192), 16, 0, 0); } while (0)
#define PG8_LDA(dst, b, h) do { _Pragma("unroll") for (int m = 0; m < 4; ++m) _Pragma("unroll") for (int k = 0; k < 2; ++k) dst[m][k] = *(const PG8_LAS bf16x8*)(lds + PG8_SA(b, h) + aoff + m * 2048 + k * 1024); } while (0)
#define PG8_LDB(dst, b, h) do { _Pragma("unroll") for (int n = 0; n < 2; ++n) _Pragma("unroll") for (int k = 0; k < 2; ++k) dst[n][k] = *(const PG8_LAS bf16x8*)(lds + PG8_SB(b, h) + boff + n * 2048 + k * 1024); } while (0)
#define PG8_MMA(ai, bj, At, Bt) do { __builtin_amdgcn_s_setprio(1); _Pragma("unroll") for (int m = 0; m < 4; ++m) _Pragma("unroll") for (int n = 0; n < 2; ++n) _Pragma("unroll") for (int k = 0; k < 2; ++k) \
        acc[ai][bj][m][n] = __builtin_amdgcn_mfma_f32_16x16x32_bf16(Bt[n][k], At[m][k], acc[ai][bj][m][n], 0, 0, 0); __builtin_amdgcn_s_setprio(0); } while (0)
#define PG8_WAIT_V(n) asm volatile("s_waitcnt vmcnt(" #n ")" ::: "memory")
#define PG8_WAIT_L(n) asm volatile("s_waitcnt lgkmcnt(" #n ")" ::: "memory")
#define PG8_BAR __builtin_amdgcn_s_barrier()
#define PG8_SCHED __builtin_amdgcn_sched_barrier(0)
    XUnit cur, nxt; int ui = 0;
    if (!S.next(0, cur)) return;
    f32x4 acc[2][2][4][2];
#pragma unroll
    for (int a = 0; a < 2; ++a)
#pragma unroll
        for (int b = 0; b < 2; ++b)
#pragma unroll
            for (int m = 0; m < 4; ++m)
#pragma unroll
                for (int n = 0; n < 2; ++n) acc[a][b][m][n] = (f32x4){0.f, 0.f, 0.f, 0.f};
    bf16x8 At[4][2], B0[2][2], B1[2][2];
    const char* cA = cur.A; const char* cB = cur.B;
    S.offs(cur, tid, K, oc0, oc1);
    S.a_ready(cur);
    if constexpr (SP2) {
        PG8_STAGE(PG8_SB(0, 0), cB, voffB); PG8_STAGE(PG8_SB(0, 1), cB + hstep, voffB); PG8_STAGE(PG8_SA(0, 0), cA, oc0); PG8_STAGE(PG8_SA(0, 1), cA, oc1);
        if (wr == 1) PG8_BAR;
        PG8_WAIT_V(2); PG8_BAR;
        PG8_STAGE(PG8_SB(1, 0), cB + kstep, voffB); PG8_STAGE(PG8_SA(1, 0), cA + kstep, oc0); PG8_STAGE(PG8_SB(1, 1), cB + hstep + kstep, voffB);
        PG8_WAIT_V(6); PG8_BAR;
    } else {
        PG8_STAGE(PG8_SB(0, 0), cB, voffB); PG8_STAGE(PG8_SA(0, 0), cA, oc0); PG8_STAGE(PG8_SB(0, 1), cB + hstep, voffB); PG8_STAGE(PG8_SA(0, 1), cA, oc1);
        if (wr == 1) PG8_BAR;
        PG8_WAIT_V(4); PG8_BAR;
        PG8_STAGE(PG8_SB(1, 0), cB + kstep, voffB); PG8_STAGE(PG8_SA(1, 0), cA + kstep, oc0); PG8_STAGE(PG8_SB(1, 1), cB + hstep + kstep, voffB);
        PG8_WAIT_V(6); PG8_BAR;
    }
    for (;;) {
        const bool has_next = S.next(ui + 1, nxt);
        const char* nA = has_next ? nxt.A : cA; const char* nB = has_next ? nxt.B : cB;
        if (has_next) S.offs(nxt, tid, K, on0, on1); else { on0[0] = oc0[0]; on0[1] = oc0[1]; on1[0] = oc1[0]; on1[1] = oc1[1]; }
        for (int t = 0; t < nt; t += 2) {
            const bool last = (t == nt - 2);
            const char* a1 = cA + (size_t)(t + 1) * kstep;
            const char* a2 = last ? nA : cA + (size_t)(t + 2) * kstep; const char* b2 = last ? nB : cB + (size_t)(t + 2) * kstep;
            const char* a3 = a2 + kstep; const char* b3 = b2 + kstep;
            unsigned s0[2], s1[2]; s0[0] = last ? on0[0] : oc0[0]; s0[1] = last ? on0[1] : oc0[1]; s1[0] = last ? on1[0] : oc1[0]; s1[1] = last ? on1[1] : oc1[1];
            if (last && has_next) S.a_ready(nxt);
            if constexpr (SP2) {
            PG8_LDB(B0, 0, 0); PG8_LDB(B1, 0, 1); PG8_SCHED; PG8_LDA(At, 0, 0); PG8_STAGE(PG8_SA(1, 1), a1, oc1);
            PG8_WAIT_V(8); PG8_WAIT_L(0); PG8_BAR; PG8_MMA(0, 0, At, B0); PG8_MMA(0, 1, At, B1); PG8_BAR; PG8_SCHED;
            PG8_LDA(At, 0, 1); PG8_STAGE(PG8_SB(0, 0), b2, voffB); PG8_STAGE(PG8_SB(0, 1), b2 + hstep, voffB); PG8_STAGE(PG8_SA(0, 0), a2, s0);
            PG8_WAIT_V(8); PG8_WAIT_L(0); PG8_BAR; PG8_MMA(1, 0, At, B0); PG8_MMA(1, 1, At, B1); PG8_BAR; PG8_SCHED;
            PG8_LDB(B0, 1, 0); PG8_LDB(B1, 1, 1); PG8_SCHED; PG8_LDA(At, 1, 0); PG8_STAGE(PG8_SA(0, 1), a2, s1);
            PG8_WAIT_V(8); PG8_WAIT_L(0); PG8_BAR; PG8_MMA(0, 0, At, B0); PG8_MMA(0, 1, At, B1); PG8_BAR; PG8_SCHED;
            PG8_LDA(At, 1, 1); PG8_STAGE(PG8_SB(1, 0), b3, voffB); PG8_STAGE(PG8_SB(1, 1), b3 + hstep, voffB); PG8_STAGE(PG8_SA(1, 0), a3, s0);
            PG8_WAIT_V(8); PG8_WAIT_L(0); PG8_BAR; PG8_MMA(1, 0, At, B0); PG8_MMA(1, 1, At, B1); PG8_BAR; PG8_SCHED;
            } else {
            PG8_LDB(B0, 0, 0); PG8_SCHED; PG8_LDA(At, 0, 0); PG8_STAGE(PG8_SA(1, 1), a1, oc1);
            PG8_WAIT_L(8); PG8_BAR; PG8_WAIT_L(0); PG8_MMA(0, 0, At, B0); PG8_BAR; PG8_SCHED;
            PG8_LDB(B1, 0, 1); PG8_STAGE(PG8_SB(0, 0), b2, voffB);
            PG8_BAR; PG8_WAIT_L(0); PG8_MMA(0, 1, At, B1); PG8_BAR;
            PG8_LDA(At, 0, 1); PG8_STAGE(PG8_SA(0, 0), a2, s0);
            PG8_BAR; PG8_WAIT_L(0); PG8_MMA(1, 0, At, B0); PG8_BAR; PG8_SCHED;
            PG8_STAGE(PG8_SB(0, 1), b2 + hstep, voffB);
            PG8_WAIT_V(6); PG8_BAR; PG8_MMA(1, 1, At, B1); PG8_BAR;
            PG8_LDB(B0, 1, 0); PG8_SCHED; PG8_LDA(At, 1, 0); PG8_STAGE(PG8_SA(0, 1), a2, s1);
            PG8_WAIT_L(8); PG8_BAR; PG8_WAIT_L(0); PG8_MMA(0, 0, At, B0); PG8_BAR; PG8_SCHED;
            PG8_LDB(B1, 1, 1); PG8_STAGE(PG8_SB(1, 0), b3, voffB);
            PG8_BAR; PG8_WAIT_L(0); PG8_MMA(0, 1, At, B1); PG8_BAR;
            PG8_LDA(At, 1, 1); PG8_STAGE(PG8_SA(1, 0), a3, s0);
            PG8_BAR; PG8_WAIT_L(0); PG8_MMA(1, 0, At, B0); PG8_BAR; PG8_SCHED;
            PG8_STAGE(PG8_SB(1, 1), b3 + hstep, voffB);
            PG8_WAIT_V(6); PG8_BAR; PG8_MMA(1, 1, At, B1); PG8_BAR;
            }
        }
        if constexpr (ALIGN_EPI) { if (wr == 0) PG8_BAR; }
        if (cur.flags & 4) E.transform(acc, cur, wr, wc, fr, fq);
        if (cur.flags & 2) E(acc, cur, wr, wc, fr, fq);
        S.after_unit(cur, tid);
        if (!has_next) break;
        if (nxt.flags & 1) {
#pragma unroll
        for (int a = 0; a < 2; ++a)
#pragma unroll
            for (int b = 0; b < 2; ++b)
#pragma unroll
                for (int m = 0; m < 4; ++m)
#pragma unroll
                    for (int n = 0; n < 2; ++n) acc[a][b][m][n] = (f32x4){0.f, 0.f, 0.f, 0.f};
        }
        cur = nxt; cA = nA; cB = nB; ++ui; oc0[0] = on0[0]; oc0[1] = on0[1]; oc1[0] = on1[0]; oc1[1] = on1[1];
        if constexpr (ALIGN_EPI) { if (wr == 1) PG8_BAR; }
    }
    PG8_WAIT_V(0);
    if constexpr (!ALIGN_EPI) { if (wr == 0) PG8_BAR; }
    PG8_BAR;
#undef PG8_SA
#undef PG8_SB
#undef PG8_STAGE
#undef PG8_LDA
#undef PG8_LDB
#undef PG8_MMA
#undef PG8_WAIT_V
#undef PG8_WAIT_L
#undef PG8_BAR
#undef PG8_SCHED
}
}

#define GAS __attribute__((address_space(1)))
#define LAS __attribute__((address_space(3)))
constexpr size_t MiB = 1u << 20;

typedef unsigned short bf16;
typedef unsigned v4u __attribute__((ext_vector_type(4)));
typedef float f32x4 __attribute__((ext_vector_type(4)));
typedef short bf16x8 __attribute__((ext_vector_type(8)));
typedef GAS unsigned gu32;
typedef GAS unsigned long long gu64;
#define RLX_AGENT __ATOMIC_RELAXED, __HIP_MEMORY_SCOPE_AGENT
#define LDS_WAIT() asm volatile("s_waitcnt lgkmcnt(0)" ::: "memory")
#define VM_WAIT() asm volatile("s_waitcnt vmcnt(0)" ::: "memory")
__device__ __forceinline__ unsigned long long rt() { return __builtin_amdgcn_s_memrealtime(); }
__device__ __forceinline__ unsigned f2bf(float f) { unsigned u = __builtin_bit_cast(unsigned, f); return (u + 0x7fffu + ((u >> 16) & 1u)) >> 16; }
__device__ __forceinline__ unsigned pk2(float lo, float hi) { return pg8::cvt_pk_bf16(lo, hi); }

#define XB_TMO      128
#define XB_XCNT(j)  (256  + 64 * (j))
#define XB_XSUB(j)  (1280 + 64 * (j))
#define XB_XGEN(j)  (2304 + 64 * (j))
#define XB_TOP      3328
#define XB_TOPGEN   3392
#define XCD_BAR_WORDS 3456
#define XB_SPIN_CAP (1u << 18)

__device__ __forceinline__ unsigned xb_ld(unsigned* p)              { return __hip_atomic_load(p, __ATOMIC_RELAXED, __HIP_MEMORY_SCOPE_AGENT); }
__device__ __forceinline__ unsigned xb_add(unsigned* p, unsigned v) { return __hip_atomic_fetch_add(p, v, __ATOMIC_RELAXED, __HIP_MEMORY_SCOPE_AGENT); }
__device__ __forceinline__ unsigned xb_xcc_id() { return (unsigned)__builtin_amdgcn_s_getreg((3 << 11) | 20) & 0xFu; }
#define XB_SPIN(cond, bar) do { unsigned _sp = 0; while (cond) { __builtin_amdgcn_s_sleep(1); \
    if ((++_sp & 255u) == 0u) { if (xb_ld(&(bar)[XB_TMO])) break; if (_sp > XB_SPIN_CAP) { atomicAdd(&(bar)[XB_TMO], 1u); break; } } } } while (0)

struct XcdBarrier {
    unsigned* bar; unsigned x;
    volatile LAS unsigned* st;
};

__device__ __forceinline__ XcdBarrier xcd_barrier_post(unsigned* bar, volatile LAS unsigned* st) {
    XcdBarrier b; b.bar = bar; b.x = xb_xcc_id(); b.st = st;
    if (threadIdx.x == 0) (void)xb_add(&bar[XB_XCNT(b.x)], 1u);
    return b;
}
__device__ __forceinline__ void xcd_barrier_complete(unsigned* bar, unsigned x, unsigned& nloc, unsigned& nx) {
    const unsigned G = gridDim.x * gridDim.y * gridDim.z;
    unsigned sum, cnt, mine, sp = 0u;
    for (;;) {
        sum = 0u; cnt = 0u; mine = 0u;
#pragma unroll
        for (unsigned j = 0; j < 16; ++j) { const unsigned c = xb_ld(&bar[XB_XCNT(j)]); sum += c; cnt += (c > 0u) ? 1u : 0u; mine = (j == x) ? c : mine; }
        if (sum == G) break;
        __builtin_amdgcn_s_sleep(1);
        if ((++sp & 255u) == 0u) { if (xb_ld(&bar[XB_TMO])) break; if (sp > XB_SPIN_CAP) { atomicAdd(&bar[XB_TMO], 1u); break; } }
    }
    nloc = mine > 0u ? mine : 1u; nx = cnt > 0u ? cnt : 1u;
}

__device__ __forceinline__ void xcd_barrier(const XcdBarrier& b) {
    asm volatile("s_waitcnt vmcnt(0)" ::: "memory");
    __syncthreads();
    if (threadIdx.x == 0) {
        unsigned* bar = b.bar;
        __builtin_amdgcn_s_waitcnt(0);
        unsigned nloc = b.st[0], nx = b.st[1];
        if (nloc == 0u) { xcd_barrier_complete(bar, b.x, nloc, nx); b.st[0] = nloc; b.st[1] = nx; }
        const unsigned old = xb_add(&bar[XB_XSUB(b.x)], 1u);
        const unsigned gen = old / nloc;
        if (old + 1u == (gen + 1u) * nloc) {
            __builtin_amdgcn_fence(__ATOMIC_RELEASE, "agent");
            asm volatile("s_waitcnt vmcnt(0)" ::: "memory");
            const unsigned og = xb_add(&bar[XB_TOP], 1u);
            const unsigned tg = og / nx;
            if (og + 1u == (tg + 1u) * nx) xb_add(&bar[XB_TOPGEN], 1u);
            else XB_SPIN(xb_ld(&bar[XB_TOPGEN]) == tg, bar);
            __builtin_amdgcn_fence(__ATOMIC_ACQUIRE, "agent");
            xb_add(&bar[XB_XGEN(b.x)], 1u);
            asm volatile("s_waitcnt vmcnt(0)" ::: "memory");
        } else {
            XB_SPIN(xb_ld(&bar[XB_TOPGEN]) == gen, bar);
            __builtin_amdgcn_fence(__ATOMIC_ACQUIRE, "agent");
            asm volatile("s_waitcnt vmcnt(0)" ::: "memory");
        }
    }
    __syncthreads();
}

constexpr int D = 1024, NB = 2, T = 8192, M = NB * T, CTXL = 256, MC = NB * CTXL, DIN = 7168, NE = 16, CAP = 1024;
constexpr float LN_EPS = 1e-6f, ALPHA = 1.189207115002721f;
constexpr size_t WS_CTL = 0, CTL_ZERO_BYTES = 1 * MiB;
constexpr int CW_TMO = 0, CW_BAR = 4096;
constexpr size_t WS_MOD = 512 * 1024;
constexpr size_t WS_TAB = 1 * MiB;
constexpr size_t WS_LN1S = 1 * MiB + 256 * 1024;
constexpr size_t WS_VSTAT = 9 * MiB;
constexpr size_t WS_KC = 2 * MiB, WS_VC = 3 * MiB;
constexpr size_t WS_WPA = 12 * MiB, WS_WPB = 14 * MiB, WS_WO = 16 * MiB;
constexpr size_t WS_WIN = 18 * MiB;
constexpr size_t WS_H = 32 * MiB;
constexpr size_t WS_Q = 66 * MiB, WS_K = 82 * MiB, WS_V = 98 * MiB, WS_SG = 130 * MiB, WS_GU = 162 * MiB, WS_GVS = 194 * MiB, WS_SGA = 226 * MiB, WS_SGB = 258 * MiB;
constexpr size_t WS_END = 322 * MiB;
constexpr int RING_OFF = 0, RING_BYTES = 131072, LDSCTL_OFF = RING_BYTES, MISC_OFF = LDSCTL_OFF + 320, LDS_BYTES = 147456;
constexpr int NWAVES = 8;

#define WSU_DPP(v, ctrl, rmask, bc) ((unsigned)__builtin_amdgcn_update_dpp(0, (int)(v), (ctrl), (rmask), 0xF, (bc)))
__device__ __forceinline__ unsigned wave_sum_u(unsigned v) {
    v += WSU_DPP(v, 0xB1, 0xF, true); v += WSU_DPP(v, 0x4E, 0xF, true); v += WSU_DPP(v, 0x141, 0xF, true); v += WSU_DPP(v, 0x140, 0xF, true);
    v += WSU_DPP(v, 0x142, 0xA, false); v += WSU_DPP(v, 0x143, 0xC, false);
    return (unsigned)__builtin_amdgcn_readlane((int)v, 63);
}
#define WS_DPP(v, ctrl, rmask, bc) __builtin_bit_cast(float, __builtin_amdgcn_update_dpp(0, __builtin_bit_cast(int, (v)), (ctrl), (rmask), 0xF, (bc)))
__device__ __forceinline__ float wave_sum(float v) {
    v += WS_DPP(v, 0xB1, 0xF, true);
    v += WS_DPP(v, 0x4E, 0xF, true);
    v += WS_DPP(v, 0x141, 0xF, true);
    v += WS_DPP(v, 0x140, 0xF, true);
    v += WS_DPP(v, 0x142, 0xA, false);
    v += WS_DPP(v, 0x143, 0xC, false);
    return __builtin_bit_cast(float, __builtin_amdgcn_readlane(__builtin_bit_cast(int, v), 63));
}
__device__ __forceinline__ float bf2f(bf16 b) { return __builtin_bit_cast(float, (unsigned)b << 16); }

__device__ __forceinline__ void p0_tr_load(f32x4 (&wv)[8], const float* W, int N, int k0, int n0, int lane) {
#pragma unroll
    for (int i = 0; i < 8; ++i) wv[i] = __builtin_nontemporal_load((const GAS f32x4*)(W + (size_t)(k0 + 8 * i + (lane >> 3)) * N + n0 + (lane & 7) * 4));
}
template <bool NTS = false>
__device__ __forceinline__ void p0_tr_finish(const f32x4 (&wv)[8], int K, bf16* WT, int k0, int dst_n0, LAS float* scr, int lane) {
#pragma unroll
    for (int i = 0; i < 8; ++i) { LAS float* d = scr + (8 * i + (lane >> 3)) * 33 + (lane & 7) * 4; d[0] = wv[i][0]; d[1] = wv[i][1]; d[2] = wv[i][2]; d[3] = wv[i][3]; }
    LDS_WAIT(); asm volatile("" ::: "memory");
    const int c = lane & 7;
#pragma unroll
    for (int j = 0; j < 4; ++j) { const int n = (lane >> 3) + 8 * j; const LAS float* s = scr + (8 * c) * 33 + n;
        v4u o; o.x = pk2(s[0 * 33], s[1 * 33]); o.y = pk2(s[2 * 33], s[3 * 33]); o.z = pk2(s[4 * 33], s[5 * 33]); o.w = pk2(s[6 * 33], s[7 * 33]);
        if (NTS) __builtin_nontemporal_store(o, (GAS v4u*)(WT + (size_t)(dst_n0 + n) * K + k0 + 8 * c)); else *(GAS v4u*)(WT + (size_t)(dst_n0 + n) * K + k0 + 8 * c) = o; }
    LDS_WAIT(); asm volatile("" ::: "memory");
}
template <bool NTS = false>
__device__ __forceinline__ void p0_transpose_item(const float* W, int K, int N, bf16* WT, int k0, int n0, int dst_n0, LAS float* scr, int lane) {
    f32x4 wv[8]; p0_tr_load(wv, W, N, k0, n0, lane); p0_tr_finish<NTS>(wv, K, WT, k0, dst_n0, scr, lane);
}
__device__ __forceinline__ int win_dst_row(int n0) { if (n0 >= 1024) return n0; const int l0 = n0 & 255; return (n0 & ~255) + 128 * ((l0 >> 5) & 1) + 32 * (l0 >> 6); }

struct Args { const float* in[29]; float* out; unsigned char* ws; int ph_lo, ph_hi, li, pad; };

__device__ __forceinline__ void p0_prologue(const Args& A, LAS unsigned char* lds, int gw, int NGW, int wave, int lane, int tid) {
    unsigned char* ws = A.ws;
    LAS float* scr = (LAS float*)(lds + RING_OFF + wave * 16384);
    const float* c = A.in[1]; const float* cctx = A.in[3]; const float* w_ada = A.in[4]; const float* b_ada = A.in[5];
    float* MOD = (float*)(ws + WS_MOD);
    if (gw - wave < 96 * 8) {
        for (int i = tid; i < 3072; i += NWAVES * 64) { const int rr = i >> 10, kk = i & 1023; const float x = rr == 0 ? c[kk] : rr == 1 ? c[1024 + kk] : cctx[kk];
            ((LAS float*)(lds + rr * 16384 + 12288))[kk] = x / (1.f + expf(-x)); } }
    __syncthreads();
    constexpr int T_GEMV = 96 * 8, I_IN = 16 * 224, I_P = 16 * 32, T_TAB = 64, NTR = I_IN + 3 * I_P;
#define P0_ITEM(J, Wp, Np, WTp, k0v, n0v, dnv) const int _j = (J); const bool _in = _j < I_IN; const int _q = _in ? _j : (_j - I_IN) % I_P, _w = _in ? 0 : (_j - I_IN) / I_P; \
        const float* Wp = _in ? A.in[6] : (_w == 0 ? A.in[16] : _w == 1 ? A.in[17] : A.in[18]); const int Np = _in ? DIN : D; \
        bf16* WTp = (bf16*)(ws + (_in ? WS_WIN : (_w == 0 ? WS_WPA : _w == 1 ? WS_WPB : WS_WO))); \
        const int k0v = 64 * (_in ? _q / 224 : _q / 32), n0v = 32 * (_in ? _q % 224 : _q % 32); const int dnv = _in ? win_dst_row(n0v) : n0v
    const bool gemv = gw < T_GEMV && NGW > T_GEMV + 64;
    const int jst = gemv ? NTR : (NGW > T_GEMV + 64 ? NGW - T_GEMV : NGW);
    int j = gemv ? gw : (NGW > T_GEMV + 64 ? T_GEMV + (gw - T_GEMV) : gw);
    if (NGW <= T_GEMV + 64) j = gw;
    { f32x4 wv[8], wn[8];
      if (j < NTR) { P0_ITEM(j, W_, N_, WT_, k0_, n0_, dn_); (void)WT_; (void)dn_; p0_tr_load(wv, W_, N_, k0_, n0_, lane); }
      for (; j < NTR; j += jst) { const int jn = j + jst;
          if (jn < NTR) { P0_ITEM(jn, Wn_, Nn_, WTn_, k0n_, n0n_, dnn_); (void)WTn_; (void)dnn_; p0_tr_load(wn, Wn_, Nn_, k0n_, n0n_, lane); }
          { P0_ITEM(j, W_, N_, WT_, k0_, n0_, dn_); (void)W_; (void)N_; (void)n0_; p0_tr_finish<false>(wv, D, WT_, k0_, dn_, scr, lane); }
#pragma unroll
          for (int i = 0; i < 8; ++i) wv[i] = wn[i]; } }
#undef P0_ITEM
    for (int r = gw; r < T_GEMV + T_TAB; r += NGW) {
        if (r < T_GEMV) {
            const int cc = r % 96, ks = r / 96; const int n = cc * 64 + lane; float a0 = 0.f, a1 = 0.f, a2 = 0.f;
            const LAS float* s0 = (const LAS float*)(lds + 0 * 16384 + 12288), * s1 = (const LAS float*)(lds + 1 * 16384 + 12288), * s2 = (const LAS float*)(lds + 2 * 16384 + 12288);
            const float* wp = w_ada + (size_t)(ks * 128) * 6144 + n;
#pragma unroll 16
            for (int k = 0; k < 128; ++k) { const float w = wp[(size_t)k * 6144]; a0 += s0[ks * 128 + k] * w; a1 += s1[ks * 128 + k] * w; a2 += s2[ks * 128 + k] * w; }
            if (ks == 0) { const float bb = b_ada[n]; a0 += bb; a1 += bb; a2 += bb; }
            atomicAdd(MOD + n, a0); atomicAdd(MOD + 6144 + n, a1); atomicAdd(MOD + 2 * 6144 + n, a2);
            continue; }
        { const int e = (r - T_GEMV) * 64 + lane; const int pos = e >> 5, f = e & 31; const float inv = powf(10000.f, -(float)f / 32.f); const float ang = (float)pos * inv;
          float* tab = (float*)(ws + WS_TAB); tab[2 * e] = cosf(ang); tab[2 * e + 1] = sinf(ang); }
    }
}
template <int NR>
__device__ __forceinline__ void p1_rows(const float* const (&xrow)[NR], bf16* const (&orow)[NR], const float* sh, const float* sc, int lane) {
    f32x4 v[NR][4], a[4], b[4];
#pragma unroll
    for (int r = 0; r < NR; ++r)
#pragma unroll
        for (int j = 0; j < 4; ++j) v[r][j] = __builtin_nontemporal_load((const GAS f32x4*)xrow[r] + lane + 64 * j);
#pragma unroll
    for (int j = 0; j < 4; ++j) { a[j] = *((const GAS f32x4*)sc + lane + 64 * j); b[j] = *((const GAS f32x4*)sh + lane + 64 * j); }
#pragma unroll
    for (int r = 0; r < NR; ++r) {
        float s = 0.f;
#pragma unroll
        for (int j = 0; j < 4; ++j) s += (v[r][j].x + v[r][j].y) + (v[r][j].z + v[r][j].w);
        const float mean = wave_sum(s) * (1.f / D); float s2 = 0.f;
#pragma unroll
        for (int j = 0; j < 4; ++j) { v[r][j] = v[r][j] - mean; s2 += (v[r][j].x * v[r][j].x + v[r][j].y * v[r][j].y) + (v[r][j].z * v[r][j].z + v[r][j].w * v[r][j].w); }
        const float rstd = 1.f / sqrtf(wave_sum(s2) * (1.f / D) + LN_EPS);
        GAS unsigned long long* o8 = (GAS unsigned long long*)orow[r] + lane;
#pragma unroll
        for (int j = 0; j < 4; ++j) { const f32x4 y = v[r][j] * rstd * (a[j] + 1.f) + b[j];
            o8[64 * j] = (unsigned long long)pk2(y.x, y.y) | ((unsigned long long)pk2(y.z, y.w) << 32); }
    }
}

constexpr int TBL_OFF = 132096, LNP_OFF = 133632;
constexpr size_t WS_STCF = 4 * MiB, WS_STCB = 5 * MiB;
constexpr size_t WS_STF = 290 * MiB, WS_STB = 18 * MiB;
__device__ __forceinline__ int img_off(int row, int chunk) { return row * 256 + ((chunk ^ (row & 15)) << 4); }
__device__ __forceinline__ unsigned bfe16(const v4u& v, int j) { return (v[j >> 1] >> (16 * (j & 1))) & 0xffffu; }
template <int MT, int NT>
__device__ __forceinline__ void mm_lds(f32x4 (&acc)[MT][NT], const LAS unsigned char* Aimg, int arow0, const LAS unsigned char* Bimg, int brow0, int fr, int fq) {
#pragma unroll
    for (int s = 0; s < 4; ++s) {
        bf16x8 a[MT], b[NT];
#pragma unroll
        for (int mt = 0; mt < MT; ++mt) a[mt] = *(const LAS bf16x8*)(Aimg + img_off(arow0 + mt * 16 + fr, 4 * s + fq));
#pragma unroll
        for (int nt = 0; nt < NT; ++nt) b[nt] = *(const LAS bf16x8*)(Bimg + img_off(brow0 + 32 * (nt >> 1) + 8 * (fr >> 2) + 4 * (nt & 1) + (fr & 3), 4 * s + fq));
#pragma unroll
        for (int mt = 0; mt < MT; ++mt)
#pragma unroll
            for (int nt = 0; nt < NT; ++nt) acc[mt][nt] = __builtin_amdgcn_mfma_f32_16x16x32_bf16(b[nt], a[mt], acc[mt][nt], 0, 0, 0);
        __builtin_amdgcn_sched_barrier(0);
    }
}
template <int MT, int NT>
__device__ __forceinline__ void mm_gB(f32x4 (&acc)[MT][NT], const LAS unsigned char* Aimg, int arow0, const bf16* Bt, int brow0, int fr, int fq) {
#pragma unroll
    for (int s = 0; s < 4; ++s) {
        bf16x8 a[MT], b[NT];
#pragma unroll
        for (int nt = 0; nt < NT; ++nt) b[nt] = *(const GAS bf16x8*)(Bt + (size_t)(brow0 + nt * 16 + fr) * 128 + 8 * (4 * s + fq));
#pragma unroll
        for (int mt = 0; mt < MT; ++mt) a[mt] = *(const LAS bf16x8*)(Aimg + img_off(arow0 + mt * 16 + fr, 4 * s + fq));
#pragma unroll
        for (int mt = 0; mt < MT; ++mt)
#pragma unroll
            for (int nt = 0; nt < NT; ++nt) acc[mt][nt] = __builtin_amdgcn_mfma_f32_16x16x32_bf16(b[nt], a[mt], acc[mt][nt], 0, 0, 0);
        __builtin_amdgcn_sched_barrier(0);
    }
}
template <int MT, int NT> __device__ __forceinline__ void zero_acc(f32x4 (&acc)[MT][NT]) {
#pragma unroll
    for (int a = 0; a < MT; ++a)
#pragma unroll
        for (int b = 0; b < NT; ++b) acc[a][b] = (f32x4){0.f, 0.f, 0.f, 0.f};
}
template <int NBLK, bool NT = false>
__device__ __forceinline__ void stage_T_load(v4u (&v0)[NBLK / 8], v4u (&v1)[NBLK / 8], const bf16* src, int wave, int lane) {
#pragma unroll
    for (int i = 0; i < NBLK / 8; ++i) { const int db = wave * (NBLK / 8) + i;
        const GAS v4u* p = (const GAS v4u*)(src + ((size_t)db * 128 + 2 * lane) * 8);
        if (NT) { v0[i] = __builtin_nontemporal_load(p); v1[i] = __builtin_nontemporal_load(p + 1); } else { v0[i] = p[0]; v1[i] = p[1]; } }
}
template <int NBLK>
__device__ __forceinline__ void stage_T_write(LAS unsigned char* img, const v4u (&v0)[NBLK / 8], const v4u (&v1)[NBLK / 8], int wave, int lane) {
    const int tp = lane;
#pragma unroll
    for (int i = 0; i < NBLK / 8; ++i) { const int db = wave * (NBLK / 8) + i;
#pragma unroll
        for (int j = 0; j < 8; ++j) { const int row = 8 * db + j; const unsigned w = bfe16(v0[i], j) | (bfe16(v1[i], j) << 16);
            *(LAS unsigned*)(img + row * 256 + (((tp >> 2) ^ (row & 15)) << 4) + (tp & 3) * 4) = w; } }
}
__device__ __forceinline__ void rows128_load(v4u (&v)[4], const bf16* src, int tid) {
#pragma unroll
    for (int i = 0; i < 4; ++i) v[i] = __builtin_nontemporal_load((const GAS v4u*)(src + (size_t)(tid + 512 * i) * 8));
}
__device__ __forceinline__ void rows128_write(LAS unsigned char* img, const v4u (&v)[4], int tid) {
#pragma unroll
    for (int i = 0; i < 4; ++i) { const int idx = tid + 512 * i, ch = idx >> 7, r = idx & 127; *(LAS v4u*)(img + img_off(r, ch)) = v[i]; }
}
__device__ __forceinline__ void rows256_load(v4u (&v)[8], const bf16* src, int tid) {
#pragma unroll
    for (int i = 0; i < 8; ++i) v[i] = __builtin_nontemporal_load((const GAS v4u*)(src + (size_t)(tid + 512 * i) * 8));
}
__device__ __forceinline__ void rows256_write(LAS unsigned char* img, const v4u (&v)[8], int tid) {
#pragma unroll
    for (int i = 0; i < 8; ++i) { const int idx = tid + 512 * i, r = idx >> 4, ch = idx & 15; *(LAS v4u*)(img + img_off(r, ch)) = v[i]; }
}
__device__ __forceinline__ v4u pack8(const f32x4& a, const f32x4& b) { v4u o; o.x = pk2(a[0], a[1]); o.y = pk2(a[2], a[3]); o.z = pk2(b[0], b[1]); o.w = pk2(b[2], b[3]); return o; }
__device__ __forceinline__ void unpack8f(const v4u& w, f32x4& a, f32x4& b) { a[0] = bf2f((bf16)(w.x & 0xffff)); a[1] = bf2f((bf16)(w.x >> 16)); a[2] = bf2f((bf16)(w.y & 0xffff)); a[3] = bf2f((bf16)(w.y >> 16)); b[0] = bf2f((bf16)(w.z & 0xffff)); b[1] = bf2f((bf16)(w.z >> 16)); b[2] = bf2f((bf16)(w.w & 0xffff)); b[3] = bf2f((bf16)(w.w >> 16)); }
__device__ __forceinline__ unsigned long long pack4(const f32x4& v) { return (unsigned long long)pk2(v[0], v[1]) | ((unsigned long long)pk2(v[2], v[3]) << 32); }

__device__ __forceinline__ void p3a_kv_fill(LAS unsigned char* lds, const v4u (&a0)[4], const v4u (&a1)[4], const v4u (&k0)[2], const v4u (&k1)[2], float lgf, float lgb, int wave, int lane) {
    LAS unsigned char* VT = lds; LAS unsigned char* KTF = lds + 65536; LAS unsigned char* KTB = lds + 98304;
    asm volatile("" : "+v"(lane));
    const int tp = lane; const float wf0 = expf((float)(127 - 2 * tp) * lgf), wf1 = expf((float)(126 - 2 * tp) * lgf), wb0 = expf((float)(2 * tp) * lgb), wb1 = expf((float)(2 * tp + 1) * lgb);
    stage_T_write<32>(VT, a0, a1, wave, lane);
#pragma unroll
    for (int i = 0; i < 2; ++i) { const int db = wave * 2 + i;
#pragma unroll
        for (int j = 0; j < 8; ++j) { const int row = 8 * db + j; const float a = bf2f((bf16)bfe16(k0[i], j)), c = bf2f((bf16)bfe16(k1[i], j));
            const int off = row * 256 + (((tp >> 2) ^ (row & 15)) << 4) + (tp & 3) * 4;
            *(LAS unsigned*)(KTF + off) = pk2(a * wf0, c * wf1); *(LAS unsigned*)(KTB + off) = pk2(a * wb0, c * wb1); } }
    __syncthreads();
}
__device__ __forceinline__ void p3a_kv_finish(LAS unsigned char* lds, bf16* stf, bf16* stb, int wave, int lane) {
    LAS unsigned char* VT = lds; LAS unsigned char* KTF = lds + 65536; LAS unsigned char* KTB = lds + 98304;
    const int wr = wave >> 2, wc = wave & 3; int fr = lane & 15, fq = lane >> 4; asm volatile("" : "+v"(fr), "+v"(fq));
#pragma unroll
    for (int dir = 0; dir < 2; ++dir) {
        f32x4 acc[8][2]; zero_acc<8, 2>(acc);
        mm_lds<8, 2>(acc, VT, wr * 128, dir == 0 ? KTF : KTB, wc * 32, fr, fq);
        bf16* st = dir == 0 ? stf : stb;
#pragma unroll
        for (int mt = 0; mt < 8; ++mt) { const int dv = wr * 128 + mt * 16 + fr, dk = wc * 32 + 8 * fq;
            *(GAS v4u*)(st + (size_t)dv * 128 + dk) = pack8(acc[mt][0], acc[mt][1]); }
    }
    __syncthreads();
}
__device__ __forceinline__ void p3a_sgu_fill(LAS unsigned char* lds, const v4u (&a0)[4], const v4u (&a1)[4], v4u (&ug)[4][2], const bf16* GU0, const float* vstat, const float* sgw, const int g, int tid, int wave, int lane) {
    LAS unsigned char* WI = lds; LAS unsigned char* VT = lds + 32768; LAS float* S12 = (LAS float*)(lds + 98304); LAS float* ST = (LAS float*)(lds + LNP_OFF);
    const int wr = wave >> 2, wc = wave & 3; int fr = lane & 15, fq = lane >> 4; asm volatile("" : "+v"(fr), "+v"(fq), "+v"(tid), "+v"(lane));
    f32x4 w0[4], w1[4]; f32x4 sv[8];
    if (tid < 128) {
#pragma unroll
        for (int i = 0; i < 8; ++i) sv[i] = *(const GAS f32x4*)(vstat + (size_t)tid * 32 + 4 * i); }
#pragma unroll
    for (int i = 0; i < 4; ++i) { const int idx = tid + 512 * i, p = idx >> 4, ch = idx & 15;
        w0[i] = *(const GAS f32x4*)(sgw + (size_t)(g * 128 + p) * 128 + 8 * ch); w1[i] = *(const GAS f32x4*)(sgw + (size_t)(g * 128 + p) * 128 + 8 * ch + 4); }
#pragma unroll
    for (int mt = 0; mt < 4; ++mt)
#pragma unroll
        for (int p2 = 0; p2 < 2; ++p2) ug[mt][p2] = *(const GAS v4u*)(GU0 + (size_t)(wr * 64 + mt * 16 + fr) * 1024 + g * 256 + wc * 64 + p2 * 32 + 8 * fq);
    if (tid < 128) { float s = 0.f, q = 0.f;
#pragma unroll
        for (int i = 0; i < 8; ++i) { s += sv[i][0] + sv[i][2]; q += sv[i][1] + sv[i][3]; }
        const float mean = s * (1.f / 1024.f), var = q * (1.f / 1024.f) - mean * mean;
        ST[2 * tid] = mean; ST[2 * tid + 1] = 1.f / sqrtf(var + LN_EPS); }
    __syncthreads();
#pragma unroll
    for (int i = 0; i < 4; ++i) { const int idx = tid + 512 * i, p = idx >> 4, ch = idx & 15;
        const f32x4 t0 = *(const LAS f32x4*)(ST + 16 * ch), t1 = *(const LAS f32x4*)(ST + 16 * ch + 4), t2 = *(const LAS f32x4*)(ST + 16 * ch + 8), t3 = *(const LAS f32x4*)(ST + 16 * ch + 12);
        float wv[8] = {w0[i][0], w0[i][1], w0[i][2], w0[i][3], w1[i][0], w1[i][1], w1[i][2], w1[i][3]};
        const float mu[8] = {t0[0], t0[2], t1[0], t1[2], t2[0], t2[2], t3[0], t3[2]}, rs[8] = {t0[1], t0[3], t1[1], t1[3], t2[1], t2[3], t3[1], t3[3]};
        float s1 = 0.f, s2 = 0.f;
#pragma unroll
        for (int j = 0; j < 8; ++j) { s2 += wv[j]; wv[j] *= rs[j]; s1 += wv[j] * mu[j]; }
#pragma unroll
        for (int o = 1; o < 16; o <<= 1) { s1 += __shfl_xor(s1, o); s2 += __shfl_xor(s2, o); }
        if (ch == 0) { S12[2 * p] = s1; S12[2 * p + 1] = s2; }
        v4u o; o.x = pk2(wv[0], wv[1]); o.y = pk2(wv[2], wv[3]); o.z = pk2(wv[4], wv[5]); o.w = pk2(wv[6], wv[7]);
        *(LAS v4u*)(WI + img_off(p, ch)) = o; }
    stage_T_write<32>(VT, a0, a1, wave, lane);
    __syncthreads();
}
__device__ __forceinline__ void p3a_sgu_finish(LAS unsigned char* lds, const v4u (&ug)[4][2], bf16* GU0, const float* lnw, const float* lnb, const float* sgb, const int g, int wave, int lane) {
    LAS unsigned char* WI = lds; LAS unsigned char* VT = lds + 32768; LAS float* S12 = (LAS float*)(lds + 98304);
    const int wr = wave >> 2, wc = wave & 3; int fr = lane & 15, fq = lane >> 4; asm volatile("" : "+v"(fr), "+v"(fq));
    f32x4 lw[4], lb[4]; float bps[4];
#pragma unroll
    for (int nt = 0; nt < 4; ++nt) { const int c = g * 256 + wc * 64 + 32 * (nt >> 1) + 8 * fq + 4 * (nt & 1); lw[nt] = *(const GAS f32x4*)(lnw + c); lb[nt] = *(const GAS f32x4*)(lnb + c); }
#pragma unroll
    for (int mt = 0; mt < 4; ++mt) bps[mt] = sgb[g * 128 + wr * 64 + mt * 16 + fr];
    f32x4 acc[4][4]; zero_acc<4, 4>(acc);
    mm_lds<4, 4>(acc, WI, wr * 64, VT, wc * 64, fr, fq);
#pragma unroll
    for (int mt = 0; mt < 4; ++mt) { const int p = wr * 64 + mt * 16 + fr; const float bp = bps[mt], s1 = S12[2 * p], s2 = S12[2 * p + 1];
#pragma unroll
        for (int p2 = 0; p2 < 2; ++p2) { f32x4 u0, u1; unpack8f(ug[mt][p2], u0, u1);
            const f32x4 o0 = (lw[2 * p2] * (acc[mt][2 * p2] - s1) + lb[2 * p2] * s2 + bp) * u0, o1 = (lw[2 * p2 + 1] * (acc[mt][2 * p2 + 1] - s1) + lb[2 * p2 + 1] * s2 + bp) * u1;
            *(GAS v4u*)(GU0 + (size_t)p * 1024 + g * 256 + wc * 64 + p2 * 32 + 8 * fq) = pack8(o0, o1); } }
    __syncthreads();
}
__device__ __forceinline__ bf16* st_slot(unsigned char* ws, int dir, int bh, int j) {
    return j < 2 ? (bf16*)(ws + (dir ? WS_STCB : WS_STCF)) + (size_t)(bh * 2 + j) * 32768 : (bf16*)(ws + (dir ? WS_STB : WS_STF)) + (size_t)(bh * 64 + (j - 2)) * 32768;
}
__device__ __forceinline__ void p3b_scan(unsigned char* ws, const float* decf, const float* decb, int gt) {
    const int dir = gt >> 16, bh = (gt >> 13) & 7, e = (gt & 8191) * 4; const int h = bh & 3;
    const float dec = dir ? decb[h] : decf[h]; const float cd = expf(-128.f * log1pf(expf(-dec)));
    f32x4 S = (f32x4){0.f, 0.f, 0.f, 0.f};
    for (int bt = 0; bt < 6; ++bt) {
        unsigned long long v[11]; GAS unsigned long long* p[11];
#pragma unroll
        for (int k = 0; k < 11; ++k) { const int i = bt * 11 + k; const int j = dir == 0 ? i : (i == 0 ? 1 : (i == 1 ? 0 : 67 - i));
            p[k] = (GAS unsigned long long*)(st_slot(ws, dir, bh, j) + e); v[k] = *p[k]; }
#pragma unroll
        for (int k = 0; k < 11; ++k) { const unsigned long long u = v[k];
            f32x4 t; t[0] = bf2f((bf16)(u & 0xffff)); t[1] = bf2f((bf16)((u >> 16) & 0xffff)); t[2] = bf2f((bf16)((u >> 32) & 0xffff)); t[3] = bf2f((bf16)(u >> 48));
            *p[k] = pack4(S); S = S * cd + t; }
    }
}
__device__ __forceinline__ void p3c_unit(LAS unsigned char* lds, const bf16* Q0, const bf16* K0, const bf16* V0, const bf16* stf, const bf16* stb, bf16* SG0,
                                         const float* gnw, const float* gnb, float lgf, float lgb, int tid, int wave, int lane) {
    LAS unsigned char* QS = lds; LAS unsigned char* KS = lds + 32768; LAS unsigned char* VT = lds + 65536;
    LAS float* PF = (LAS float*)(lds + TBL_OFF); LAS float* PB = PF + 132; LAS float* LNP = (LAS float*)(lds + LNP_OFF);
    const int wr = wave >> 2, wc = wave & 3; int fr = lane & 15, fq = lane >> 4; asm volatile("" : "+v"(fr), "+v"(fq), "+v"(tid), "+v"(lane));
    { v4u q[4], k[4], a0[4], a1[4];
      rows128_load(q, Q0, tid); rows128_load(k, K0, tid); stage_T_load<32, true>(a0, a1, V0, wave, lane);
      if (tid < 129) PF[tid] = expf((float)tid * lgf); else if (tid >= 256 && tid < 256 + 129) PB[tid - 256] = expf((float)(tid - 256) * lgb);
      rows128_write(QS, q, tid); rows128_write(KS, k, tid); stage_T_write<32>(VT, a0, a1, wave, lane); }
    __syncthreads();
    f32x4 sc[4][2]; zero_acc<4, 2>(sc);
    mm_lds<4, 2>(sc, QS, wr * 64, KS, wc * 32, fr, fq);
    v4u sst[8]; rows256_load(sst, stf, tid);
    __syncthreads();
#pragma unroll
    for (int mt = 0; mt < 4; ++mt) { const int l = wr * 64 + mt * 16 + fr; f32x4 v[2];
#pragma unroll
        for (int nt = 0; nt < 2; ++nt) { const int m0 = wc * 32 + 8 * fq + 4 * nt;
#pragma unroll
            for (int i = 0; i < 4; ++i) { const int d = l - (m0 + i); const float mk = (d >= 0 ? PF[d >= 0 ? d : 0] : 0.f) + (d <= 0 ? PB[d <= 0 ? -d : 0] : 0.f); v[nt][i] = sc[mt][nt][i] * mk; } }
        *(LAS v4u*)(KS + img_off(l, wc * 4 + fq)) = pack8(v[0], v[1]); }
    __syncthreads();
    f32x4 o[4][4]; zero_acc<4, 4>(o);
    mm_lds<4, 4>(o, KS, wr * 64, VT, wc * 64, fr, fq);
    __syncthreads();
    rows256_write(VT, sst, tid);
    rows256_load(sst, stb, tid);
    __syncthreads();
    {
        f32x4 p[4][4]; zero_acc<4, 4>(p);
        mm_lds<4, 4>(p, QS, wr * 64, VT, wc * 64, fr, fq);
#pragma unroll
        for (int mt = 0; mt < 4; ++mt) { const float s = PF[wr * 64 + mt * 16 + fr + 1];
#pragma unroll
            for (int nt = 0; nt < 4; ++nt) o[mt][nt] += p[mt][nt] * s; }
        __syncthreads();
        rows256_write(VT, sst, tid);
        __syncthreads();
        zero_acc<4, 4>(p);
        mm_lds<4, 4>(p, QS, wr * 64, VT, wc * 64, fr, fq);
#pragma unroll
        for (int mt = 0; mt < 4; ++mt) { const float s = PB[128 - (wr * 64 + mt * 16 + fr)];
#pragma unroll
            for (int nt = 0; nt < 4; ++nt) o[mt][nt] += p[mt][nt] * s; }
    }
#pragma unroll
    for (int mt = 0; mt < 4; ++mt) { float s = 0.f, q = 0.f;
#pragma unroll
        for (int nt = 0; nt < 4; ++nt)
#pragma unroll
            for (int i = 0; i < 4; ++i) { const float x = o[mt][nt][i]; s += x; q += x * x; }
        s += __shfl_xor(s, 16); s += __shfl_xor(s, 32); q += __shfl_xor(q, 16); q += __shfl_xor(q, 32);
        if (fq == 0) { const int l = wr * 64 + mt * 16 + fr; LNP[(l * 4 + wc) * 2] = s; LNP[(l * 4 + wc) * 2 + 1] = q; } }
    f32x4 gw4[4], gb4[4]; v4u ug[4][2];
#pragma unroll
    for (int nt = 0; nt < 4; ++nt) { const int dv = wc * 64 + 32 * (nt >> 1) + 8 * fq + 4 * (nt & 1); gw4[nt] = *(const GAS f32x4*)(gnw + dv); gb4[nt] = *(const GAS f32x4*)(gnb + dv); }
#pragma unroll
    for (int mt = 0; mt < 4; ++mt)
#pragma unroll
        for (int p2 = 0; p2 < 2; ++p2) ug[mt][p2] = *(const GAS v4u*)(SG0 + (size_t)(wr * 64 + mt * 16 + fr) * 1024 + wc * 64 + p2 * 32 + 8 * fq);
    __syncthreads();
#pragma unroll
    for (int mt = 0; mt < 4; ++mt) { const int l = wr * 64 + mt * 16 + fr; float s = 0.f, q = 0.f;
#pragma unroll
        for (int w = 0; w < 4; ++w) { s += LNP[(l * 4 + w) * 2]; q += LNP[(l * 4 + w) * 2 + 1]; }
        const float mean = s * (1.f / 256.f), rstd = 1.f / sqrtf(q * (1.f / 256.f) - mean * mean + LN_EPS);
#pragma unroll
        for (int p2 = 0; p2 < 2; ++p2) { f32x4 u0, u1; unpack8f(ug[mt][p2], u0, u1);
            const f32x4 y0 = ((o[mt][2 * p2] - mean) * rstd * gw4[2 * p2] + gb4[2 * p2]) * u0, y1 = ((o[mt][2 * p2 + 1] - mean) * rstd * gw4[2 * p2 + 1] + gb4[2 * p2 + 1]) * u1;
            *(GAS v4u*)(SG0 + (size_t)l * 1024 + wc * 64 + p2 * 32 + 8 * fq) = pack8(y0, y1); } }
    __syncthreads();
}

constexpr size_t WS_Y = WS_Q;
constexpr size_t WS_H2 = WS_V;
__device__ __forceinline__ int rimg(int row, int c) { return row * 2048 + ((c ^ (row & 15)) << 4); }
__device__ __forceinline__ float row_max16(float v) {
    v = fmaxf(v, WS_DPP(v, 0xB1, 0xF, true)); v = fmaxf(v, WS_DPP(v, 0x4E, 0xF, true)); v = fmaxf(v, WS_DPP(v, 0x141, 0xF, true)); v = fmaxf(v, WS_DPP(v, 0x140, 0xF, true));
    return v;
}
__device__ __forceinline__ float row_sum16b(float v) {
    v += WS_DPP(v, 0xB1, 0xF, true); v += WS_DPP(v, 0x4E, 0xF, true); v += WS_DPP(v, 0x141, 0xF, true); v += WS_DPP(v, 0x140, 0xF, true);
    return v;
}
__device__ __forceinline__ void p4c_rows(const int ROWS, const float* xrow0, float* ln1s, bf16* hrow0, float* aff_b, const int tok0, const LAS float* par,
                                         LAS unsigned char* lds, const bf16x8 (&bh)[4], const bf16x8 (&bl)[4], const float* br, int wave, int lane) {
  LAS unsigned char* AH = lds; LAS unsigned char* AL = lds + 32768; LAS float* RED = (LAS float*)(lds + 81920);
  const int fr = lane & 15, fq = lane >> 4;
  f32x4 cur[2][4], nxt[2][4];
  f32x4 PW[4], PB[4], PA[4], PS[4];
#pragma unroll
  for (int j = 0; j < 4; ++j) { const LAS f32x4* q = (const LAS f32x4*)par + lane + 64 * j; PW[j] = q[0]; PB[j] = q[256]; PA[j] = q[512]; PS[j] = q[768]; }
#pragma unroll
  for (int r = 0; r < 2; ++r)
#pragma unroll
    for (int j = 0; j < 4; ++j) cur[r][j] = __builtin_nontemporal_load((const GAS f32x4*)(xrow0 + (size_t)r * D) + lane + 64 * j);
#pragma unroll 1
  for (int t = 0; t < ROWS; t += 2) {
    if (t + 2 < ROWS) {
#pragma unroll
      for (int r = 0; r < 2; ++r)
#pragma unroll
        for (int j = 0; j < 4; ++j) nxt[r][j] = __builtin_nontemporal_load((const GAS f32x4*)(xrow0 + (size_t)(t + 2 + r) * D) + lane + 64 * j); }
#pragma unroll
    for (int r = 0; r < 2; ++r) {
      f32x4 v[4]; float s = 0.f;
#pragma unroll
      for (int j = 0; j < 4; ++j) { v[j] = cur[r][j]; s += (v[j].x + v[j].y) + (v[j].z + v[j].w); }
      float mean = wave_sum(s) * (1.f / D), s2 = 0.f;
#pragma unroll
      for (int j = 0; j < 4; ++j) { v[j] = v[j] - mean; s2 += (v[j].x * v[j].x + v[j].y * v[j].y) + (v[j].z * v[j].z + v[j].w * v[j].w); }
      float rstd = 1.f / sqrtf(wave_sum(s2) * (1.f / D) + LN_EPS);
      s = 0.f;
#pragma unroll
      for (int j = 0; j < 4; ++j) {
          v[j] = v[j] * rstd * PW[j] + PB[j]; s += (v[j].x + v[j].y) + (v[j].z + v[j].w); }
      if (lane == 0) { ln1s[2 * (t + r)] = mean; ln1s[2 * (t + r) + 1] = rstd; }
      mean = wave_sum(s) * (1.f / D); s2 = 0.f;
#pragma unroll
      for (int j = 0; j < 4; ++j) { v[j] = v[j] - mean; s2 += (v[j].x * v[j].x + v[j].y * v[j].y) + (v[j].z * v[j].z + v[j].w * v[j].w); }
      rstd = 1.f / sqrtf(wave_sum(s2) * (1.f / D) + LN_EPS);
      GAS unsigned long long* o8 = (GAS unsigned long long*)(hrow0 + (size_t)(t + r) * D) + lane;
      const int R = 2 * wave + r;
#pragma unroll
      for (int j = 0; j < 4; ++j) {
          v[j] = v[j] * rstd * PA[j] + PS[j];
          const unsigned h0 = pk2(v[j].x, v[j].y), h1 = pk2(v[j].z, v[j].w);
          o8[64 * j] = (unsigned long long)h0 | ((unsigned long long)h1 << 32);
          const float lx = v[j].x - __builtin_bit_cast(float, h0 << 16), ly = v[j].y - __builtin_bit_cast(float, h0 & 0xffff0000u), lz = v[j].z - __builtin_bit_cast(float, h1 << 16), lw = v[j].w - __builtin_bit_cast(float, h1 & 0xffff0000u);
          const unsigned l0 = pk2(lx, ly), l1 = pk2(lz, lw);
          const int off = rimg(R, (lane >> 1) + 32 * j) + 8 * (lane & 1);
          *(LAS unsigned long long*)(AH + off) = (unsigned long long)h0 | ((unsigned long long)h1 << 32);
          *(LAS unsigned long long*)(AL + off) = (unsigned long long)l0 | ((unsigned long long)l1 << 32); }
      asm volatile("" ::: "memory");
    }
    __syncthreads();
    { f32x4 acc = (f32x4){0.f, 0.f, 0.f, 0.f};
#pragma unroll
      for (int ks = 0; ks < 4; ++ks) { const int c = 16 * wave + 4 * ks + fq;
          const bf16x8 ah = *(const LAS bf16x8*)(AH + rimg(fr, c)), al = *(const LAS bf16x8*)(AL + rimg(fr, c));
          acc = __builtin_amdgcn_mfma_f32_16x16x32_bf16(bh[ks], ah, acc, 0, 0, 0);
          acc = __builtin_amdgcn_mfma_f32_16x16x32_bf16(bl[ks], ah, acc, 0, 0, 0);
          acc = __builtin_amdgcn_mfma_f32_16x16x32_bf16(bh[ks], al, acc, 0, 0, 0); }
      *(LAS f32x4*)(RED + wave * 256 + fr * 16 + 4 * fq) = acc; }
    __syncthreads();
    { const int r = (lane >> 4) & 1, e = lane & 15, R = 2 * wave + r; float lgt = br[e];
#pragma unroll
      for (int q = 0; q < 8; ++q) lgt += RED[q * 256 + R * 16 + e];
      const float mx = row_max16(lgt); const float ex = expf(lgt - mx); const float sum = row_sum16b(ex);
      if (lane < 32) aff_b[(size_t)e * T + tok0 + t + r] = ex / sum; }
#pragma unroll
    for (int r = 0; r < 2; ++r)
#pragma unroll
      for (int j = 0; j < 4; ++j) cur[r][j] = nxt[r][j];
  }
}

constexpr size_t WS_AFFT = 6 * MiB;
constexpr size_t WS_IDX = 7 * MiB;
constexpr size_t WS_GATEW = 7 * MiB + 512 * 1024;
constexpr size_t WS_SLOT = 8 * MiB;
constexpr size_t WS_X1 = 130 * MiB;
constexpr size_t WS_WD = 194 * MiB;
constexpr size_t WS_HID = 226 * MiB;
constexpr size_t WS_YE = 18 * MiB;
__device__ __forceinline__ unsigned block_excl_scan(unsigned v, LAS unsigned* wsum, int wave, int lane) {
    unsigned inc = v;
#pragma unroll
    for (int o = 1; o < 64; o <<= 1) { const unsigned t = __shfl_up(inc, o); if (lane >= o) inc += t; }
    if (lane == 63) wsum[wave] = inc;
    __syncthreads();
    unsigned base = 0;
#pragma unroll
    for (int w = 0; w < 8; ++w) base += (w < wave) ? wsum[w] : 0u;
    __syncthreads();
    return base + inc - v;
}
__device__ __forceinline__ void p5_topk(LAS unsigned char* lds, const float* aff, int* idx, float* gatew, int* slot, int tid, int wave, int lane) {
    LAS unsigned* wsum = (LAS unsigned*)lds;
    unsigned key[16];
#pragma unroll
    for (int i = 0; i < 4; ++i) { const f32x4 v = *((const GAS f32x4*)(aff + tid * 16) + i);
#pragma unroll
        for (int j = 0; j < 4; ++j) { const float f = v[j]; key[4 * i + j] = __float_as_uint(f); } }
    unsigned thr_ = 0u;
#pragma unroll 1
    for (int b0 = 30; b0 >= 0; b0 -= 2) {
        const unsigned t1 = thr_ + (1u << b0), t2 = thr_ + (2u << b0), t3 = thr_ + (3u << b0); unsigned p01 = 0u, p2 = 0u;
#pragma unroll
        for (int i = 0; i < 16; ++i) { p01 += (key[i] >= t1 ? 1u : 0u) + (key[i] >= t2 ? 0x10000u : 0u); p2 += (key[i] >= t3) ? 1u : 0u; }
        p01 = wave_sum_u(p01); p2 = wave_sum_u(p2);
        const int par = (b0 >> 1) & 1;
        if (lane == 0) { wsum[par * 16 + 2 * wave] = p01; wsum[par * 16 + 2 * wave + 1] = p2; }
        __syncthreads();
        unsigned n1 = 0u, n2 = 0u, n3 = 0u;
#pragma unroll
        for (int w = 0; w < 8; ++w) { const unsigned a = wsum[par * 16 + 2 * w], b = wsum[par * 16 + 2 * w + 1]; n1 += a & 0xffffu; n2 += a >> 16; n3 += b; }
        thr_ = n3 >= 1024u ? t3 : (n2 >= 1024u ? t2 : (n1 >= 1024u ? t1 : thr_));
    }
    __syncthreads();
    unsigned gt = 0u;
#pragma unroll
    for (int i = 0; i < 16; ++i) gt += (key[i] > thr_) ? 1u : 0u;
    gt = wave_sum_u(gt);
    if (lane == 0) wsum[32 + wave] = gt;
    __syncthreads();
    unsigned gtot = 0u;
#pragma unroll
    for (int w = 0; w < 8; ++w) gtot += wsum[32 + w];
    const unsigned prefix = thr_, need = 1024u - gtot;
    __syncthreads();
    const unsigned thr = prefix;
    unsigned eq = 0u;
#pragma unroll
    for (int i = 0; i < 16; ++i) eq += (key[i] == thr) ? 1u : 0u;
    unsigned e2 = block_excl_scan(eq, wsum, wave, lane);
    unsigned selmask = 0u, cnt = 0u;
#pragma unroll
    for (int i = 0; i < 16; ++i) { bool s = key[i] > thr; if (key[i] == thr) { s = e2 < need; ++e2; } if (s) { selmask |= 1u << i; ++cnt; } }
    unsigned base = block_excl_scan(cnt, wsum, wave, lane);
    LAS int* slotL = (LAS int*)(lds + 1024); LAS int* idxL = slotL + 8192; LAS float* gwL = (LAS float*)(idxL + 1024);
#pragma unroll
    for (int i = 0; i < 16; ++i) { const int t = tid * 16 + i;
        if ((selmask >> i) & 1u) { idxL[base] = t; gwL[base] = __builtin_bit_cast(float, key[i]); slotL[t] = (int)base; ++base; } else slotL[t] = -1; }
    __syncthreads();
    typedef int i32x4 __attribute__((ext_vector_type(4)));
#pragma unroll
    for (int q = 0; q < 4; ++q) *((GAS i32x4*)slot + tid + 512 * q) = *((const LAS i32x4*)slotL + tid + 512 * q);
    if (tid < 256) *((GAS i32x4*)idx + tid) = *((const LAS i32x4*)idxL + tid); else *((GAS f32x4*)gatew + (tid - 256)) = *((const LAS f32x4*)gwL + (tid - 256));
}
__device__ __forceinline__ void p8_gather(f32x4 (&acc)[4], const bf16* YE, int myslot, int b, int lane) {
#pragma unroll
    for (int j = 0; j < 4; ++j) acc[j] = (f32x4){0.f, 0.f, 0.f, 0.f};
    unsigned bal = (unsigned)__ballot(myslot >= 0 && lane < 16);
    while (bal) {
        const int e0 = __builtin_ctz(bal); bal &= bal - 1; const bool two = bal != 0u; const int e1 = two ? __builtin_ctz(bal) : e0; if (two) bal &= bal - 1;
        const int s0 = __shfl(myslot, e0), s1 = __shfl(myslot, e1);
        const GAS unsigned long long* y0 = (const GAS unsigned long long*)(YE + ((size_t)((b * 16 + e0) * 1024 + s0)) * 1024) + lane;
        const GAS unsigned long long* y1 = (const GAS unsigned long long*)(YE + ((size_t)((b * 16 + e1) * 1024 + s1)) * 1024) + lane;
        unsigned long long u0[4], u1[4];
#pragma unroll
        for (int j = 0; j < 4; ++j) { u0[j] = __builtin_nontemporal_load(y0 + 64 * j); u1[j] = __builtin_nontemporal_load(y1 + 64 * j); }
        const float f1 = two ? 1.f : 0.f;
#pragma unroll
        for (int j = 0; j < 4; ++j) { const unsigned long long u = u0[j], w = u1[j];
            acc[j][0] += bf2f((bf16)(u & 0xffff)) + f1 * bf2f((bf16)(w & 0xffff)); acc[j][1] += bf2f((bf16)((u >> 16) & 0xffff)) + f1 * bf2f((bf16)((w >> 16) & 0xffff));
            acc[j][2] += bf2f((bf16)((u >> 32) & 0xffff)) + f1 * bf2f((bf16)((w >> 32) & 0xffff)); acc[j][3] += bf2f((bf16)(u >> 48)) + f1 * bf2f((bf16)(w >> 48)); }
    }
}
__device__ __forceinline__ void p8_rows2(const float* xrow0, const float* ln1s, const float* l1w, const float* l1b, float* orow0, const bf16* YE, const int sl0, const int sl1, int b, const float* g2, const float* l2w, const float* l2b, int lane) {
    f32x4 x[2][4], g[4], w[4], bb[4];
#pragma unroll
    for (int r = 0; r < 2; ++r)
#pragma unroll
        for (int j = 0; j < 4; ++j) x[r][j] = __builtin_nontemporal_load((const GAS f32x4*)(xrow0 + (size_t)r * D) + lane + 64 * j);
#pragma unroll
    for (int j = 0; j < 4; ++j) { g[j] = *((const GAS f32x4*)g2 + lane + 64 * j); w[j] = *((const GAS f32x4*)l2w + lane + 64 * j); bb[j] = *((const GAS f32x4*)l2b + lane + 64 * j); }
    f32x4 w1[4], b1[4]; const f32x4 st = *(const GAS f32x4*)ln1s;
#pragma unroll
    for (int j = 0; j < 4; ++j) { w1[j] = *((const GAS f32x4*)l1w + lane + 64 * j); b1[j] = *((const GAS f32x4*)l1b + lane + 64 * j); }
    f32x4 acc[2][4];
    p8_gather(acc[0], YE, sl0, b, lane); p8_gather(acc[1], YE, sl1, b, lane);
#pragma unroll
    for (int r = 0; r < 2; ++r) {
        GAS f32x4* xr = (GAS f32x4*)(orow0 + (size_t)r * D) + lane;
        f32x4 v[4]; float s = 0.f;
#pragma unroll
        for (int j = 0; j < 4; ++j) { const f32x4 x1 = (x[r][j] - st[2 * r]) * st[2 * r + 1] * w1[j] + b1[j]; v[j] = x1 * ALPHA + g[j] * acc[r][j]; s += (v[j].x + v[j].y) + (v[j].z + v[j].w); }
        const float mean = wave_sum(s) * (1.f / D); float s2 = 0.f;
#pragma unroll
        for (int j = 0; j < 4; ++j) { v[j] = v[j] - mean; s2 += (v[j].x * v[j].x + v[j].y * v[j].y) + (v[j].z * v[j].z + v[j].w * v[j].w); }
        const float rstd = 1.f / sqrtf(wave_sum(s2) * (1.f / D) + LN_EPS);
#pragma unroll
        for (int j = 0; j < 4; ++j) __builtin_nontemporal_store(v[j] * rstd * w[j] + bb[j], xr + 64 * j);
    }
}

#define MOE_ITEM(ID, Wp, WTp, k0v, n0v, dnv) const int _id = (ID); const int _g = _id < 16384; const int _it = _g ? _id : _id - 16384; const int _mat = _g ? (_it >> 13) : 2; \
    const int _e = (_it >> 9) & 15, _q = _it & 511; const int k0v = 64 * (_q >> 5), n0v = 32 * (_q & 31); \
    const float* Wp = (_mat == 0 ? args.in[24] : _mat == 1 ? args.in[25] : args.in[26]) + (size_t)_e * D * D; \
    bf16* WTp = _g ? (bf16*)args.out + (size_t)_e * 2048 * 1024 : (bf16*)(ws + WS_WD) + (size_t)_e * 1024 * 1024; \
    const int dnv = _g ? 256 * (n0v >> 7) + (n0v & 127) + 128 * _mat : n0v
#define MOE_COPY_LOOP(lo, hi) do { f32x4 wv[8], wn[8]; int it = (lo) + cw; \
        if (it < (hi)) { MOE_ITEM(it, W_, WT_, k0_, n0_, dn_); (void)WT_; (void)dn_; p0_tr_load(wv, W_, D, k0_, n0_, lane); } \
        for (; it < (hi); it += NCW) { const int itn = it + NCW; \
            if (itn < (hi)) { MOE_ITEM(itn, Wn_, WTn_, k0n_, n0n_, dnn_); (void)WTn_; (void)dnn_; p0_tr_load(wn, Wn_, D, k0n_, n0n_, lane); } \
            { MOE_ITEM(it, W_, WT_, k0_, n0_, dn_); (void)W_; (void)n0_; p0_tr_finish<true>(wv, D, WT_, k0_, dn_, scr, lane); } \
            _Pragma("unroll") for (int i = 0; i < 8; ++i) wv[i] = wn[i]; } } while (0)
#define MOE_COPY_STREAM(ID0, STRIDE, K0, KSTEP, KEND, STOP, KOUT) do { f32x4 wv[8], wn[8]; int k = (K0); \
        if (k < (KEND)) { MOE_ITEM((ID0) + (STRIDE) * k, W_, WT_, k0_, n0_, dn_); (void)WT_; (void)dn_; p0_tr_load(wv, W_, D, k0_, n0_, lane); } \
        while (k < (KEND)) { const bool stop_ = (STOP); const int kn = k + (KSTEP); \
            if (kn < (KEND) && !stop_) { MOE_ITEM((ID0) + (STRIDE) * kn, Wn_, WTn_, k0n_, n0n_, dnn_); (void)WTn_; (void)dnn_; p0_tr_load(wn, Wn_, D, k0n_, n0n_, lane); } \
            { MOE_ITEM((ID0) + (STRIDE) * k, W_, WT_, k0_, n0_, dn_); (void)W_; (void)n0_; p0_tr_finish<true>(wv, D, WT_, k0_, dn_, scr, lane); } \
            k = kn; if (stop_) break; _Pragma("unroll") for (int i = 0; i < 8; ++i) wv[i] = wn[i]; } (KOUT) = k; } while (0)
constexpr int NCS = 192, CS_ITEMS = 24576 / NCS;
constexpr int CS_P2 = 73, CS_GU = 85, POOLB0 = NCS * CS_P2, POOLB_WGS = 36;
static_assert(NCS * CS_GU <= 16384 && POOLB0 + POOLB_WGS * NWAVES * 8 == NCS * CS_GU, "P2 converts gate / up items only");
constexpr int P2_TAIL_ITEMS = 9728;
__global__ void __launch_bounds__(NWAVES * 64, 2) mk_fwd(Args args) {
    extern __shared__ __attribute__((aligned(16))) unsigned char lds_raw[];
    LAS unsigned char* lds = (LAS unsigned char*)lds_raw;
    volatile LAS unsigned* MISC = (volatile LAS unsigned*)(lds + MISC_OFF);
    const int tid = threadIdx.x, lane = tid & 63, wave = __builtin_amdgcn_readfirstlane(tid >> 6);
    const int G = gridDim.x; const int bx = blockIdx.x; const int vcu = (G % 8 == 0) ? (bx % 8) * (G / 8) + bx / 8 : bx;
    unsigned char* ws = args.ws;
    gu32* ctl = (gu32*)(ws + WS_CTL);
    for (int u = tid; u < (LDS_BYTES - LDSCTL_OFF) / 4; u += NWAVES * 64) ((LAS unsigned*)(lds + LDSCTL_OFF))[u] = 0u;
    __syncthreads();
    XcdBarrier bar = xcd_barrier_post((unsigned*)(ctl + CW_BAR) + args.li * XCD_BAR_WORDS, MISC + 8);
    const int lo = args.ph_lo, hi = args.ph_hi;
#ifdef PH_ONLY
#define PHON(k) ((k) == PH_ONLY)
#else
#define PHON(k) true
#endif
#define IN(k) (lo <= (k) && (k) < hi)
#ifdef DIAG_A
#define STAMP(k) do { if (blockIdx.x == 0 && tid == 0) { ((unsigned long long*)(ws + 768 * 1024))[(k)] = rt(); } } while (0)
#else
#define STAMP(k) do {} while (0)
#endif
#define BOTH(k) (IN(k) && IN((k) + 1))
    const int gw = vcu * NWAVES + wave, NGW = G * NWAVES;
    STAMP(0);
    if (PHON(0) && IN(0)) { p0_prologue(args, lds, gw, NGW, wave, lane, tid); if (BOTH(0)) xcd_barrier(bar); STAMP(0 + 1); }
    if (PHON(1) && IN(1)) {
        const float* MOD = (const float*)(ws + WS_MOD); bf16* H = (bf16*)(ws + WS_H);
        for (int m0 = gw * 2; m0 < M; m0 += NGW * 2) {
            const float* xr[2]; bf16* orr[2]; const int bb = m0 >> 13;
#pragma unroll
            for (int r = 0; r < 2; ++r) { const int m = m0 + r; xr[r] = args.in[0] + (size_t)m * D; orr[r] = H + (size_t)m * D; }
            p1_rows<2>(xr, orr, MOD + bb * 6144, MOD + bb * 6144 + D, lane);
        }
        for (int mc = gw; mc < MC; mc += NGW) {
            const float* xr[1] = {args.in[2] + (size_t)mc * D}; bf16* orr[1] = {H + (size_t)(M + mc) * D};
            p1_rows<1>(xr, orr, MOD + 2 * 6144, MOD + 2 * 6144 + D, lane);
        }
        if (BOTH(1)) xcd_barrier(bar); STAMP(1 + 1);
    }
    if (PHON(2) && IN(2)) {
        unsigned* ctxflag = (unsigned*)(ws + WS_CTL) + 1024;
        unsigned* p2done = ctxflag + 32; unsigned* cprog = ctxflag + 1024;
        const bool split = (G == 256);
        if (split && (int)blockIdx.x >= pg8::NG2) {
            LAS float* scr = (LAS float*)(lds + RING_OFF + wave * 16384);
            const int w = ((int)blockIdx.x - pg8::NG2) * NWAVES + wave; int kdone = 0;
            MOE_COPY_STREAM(w, NCS, 0, 1, CS_P2, __hip_atomic_load(p2done, __ATOMIC_RELAXED, __HIP_MEMORY_SCOPE_AGENT) >= 60u, kdone);
            if (lane == 0) cprog[w] = (unsigned)kdone;
        } else {
        pg8::SchedP2 S; S.init(split ? pg8::NG2 : G, (int)blockIdx.x, ws + WS_H, ws + WS_WIN, ctxflag, split);
        static_assert(WS_K == WS_Q + 16 * MiB && WS_SG == WS_V + 32 * MiB && WS_GU == WS_V + 64 * MiB && WS_GVS == WS_V + 96 * MiB && WS_SGA == WS_V + 128 * MiB && WS_SGB == WS_V + 160 * MiB, "section spacing");
        pg8::EpiZ E{(bf16*)(ws + WS_Q), (bf16*)(ws + WS_V), (bf16*)(ws + WS_KC), (bf16*)(ws + WS_VC), args.in[7], (const float*)(ws + WS_TAB), (float*)(ws + WS_VSTAT)};
        pg8::gemm_phase<pg8::EpiZ, pg8::SchedP2, true, true>(lds + RING_OFF, D, S, E);
        if (split) {
            if (tid == 0) __hip_atomic_fetch_add(p2done, 1u, __ATOMIC_RELAXED, __HIP_MEMORY_SCOPE_AGENT);
            const int ti = (int)blockIdx.x - (pg8::CF0 + 12);
            if (ti >= 0 && ti < 16) {
                if (tid == 0) { unsigned sp = 0;
                    while (__hip_atomic_load(ctxflag, __ATOMIC_RELAXED, __HIP_MEMORY_SCOPE_AGENT) < 12u) { __builtin_amdgcn_s_sleep(8); if (++sp > (1u << 22)) { __hip_atomic_store((unsigned*)(ws + WS_CTL) + CW_TMO, 1u, __ATOMIC_RELAXED, __HIP_MEMORY_SCOPE_AGENT); break; } }
                    __builtin_amdgcn_fence(__ATOMIC_ACQUIRE, "agent"); asm volatile("s_waitcnt vmcnt(0)" ::: "memory"); }
                __syncthreads();
                const int cu = ti, bh = cu >> 1, j = cu & 1, h = bh & 3; const float* decf = args.in[8]; const float* decb = args.in[9];
                const float lgf = -log1pf(expf(-decf[h])), lgb = -log1pf(expf(-decb[h]));
                v4u A0[4], A1[4], K0[2], K1[2];
                stage_T_load<32>(A0, A1, (const bf16*)(ws + WS_VC) + (size_t)cu * 32768, wave, lane); stage_T_load<16>(K0, K1, (const bf16*)(ws + WS_KC) + (size_t)cu * 16384, wave, lane);
                p3a_kv_fill(lds, A0, A1, K0, K1, lgf, lgb, wave, lane);
                p3a_kv_finish(lds, st_slot(ws, 0, bh, j), st_slot(ws, 1, bh, j), wave, lane);
            } else if (ti >= 16 && ti < 16 + POOLB_WGS) {
                LAS float* scr = (LAS float*)(lds + RING_OFF + wave * 16384);
                const int bw = (ti - 16) * NWAVES + wave; int kd_ = 0;
                MOE_COPY_STREAM(POOLB0 + bw, POOLB_WGS * NWAVES, 0, 1, 8, false, kd_); (void)kd_;
            } } }
        if (BOTH(2)) xcd_barrier(bar); STAMP(2 + 1);
    }

    if (PHON(3) && IN(3)) {
        const float* decf = args.in[8]; const float* decb = args.in[9];
        v4u A0[4], A1[4], K0[2], K1[2];
#define P3A_PREFETCH(LL) do { const int _L = (LL); \
            if (_L < 512) { stage_T_load<32, true>(A0, A1, (const bf16*)(ws + WS_GVS) + (size_t)((((_L >> 8) * 64 + ((_L >> 2) & 63)) * 4 + (_L & 3))) * 32768, wave, lane); } \
            else { const int _u = _L - 512; const bf16* _Ks; const bf16* _Vs; \
                if (_u < 512) { _Ks = (const bf16*)(ws + WS_K) + (size_t)_u * 16384; _Vs = (const bf16*)(ws + WS_V) + (size_t)_u * 32768; }        \
                else { const int _cu = _u - 512; _Ks = (const bf16*)(ws + WS_KC) + (size_t)_cu * 16384; _Vs = (const bf16*)(ws + WS_VC) + (size_t)_cu * 32768; }     \
                stage_T_load<32>(A0, A1, _Vs, wave, lane); stage_T_load<16>(K0, K1, _Ks, wave, lane); } } while (0)
        const int NU3 = G == 256 ? 1024 : 1040;
        if (vcu < NU3) P3A_PREFETCH(vcu);
        for (int L = vcu; L < NU3; L += G) {
            if (L < 512) { const size_t r0 = (size_t)(L >> 8) * T + (size_t)((L >> 2) & 63) * 128; const int g = L & 3; bf16* GU0 = (bf16*)(ws + WS_GU) + r0 * 1024;
                v4u UG[4][2];
                p3a_sgu_fill(lds, A0, A1, UG, GU0, (const float*)(ws + WS_VSTAT) + r0 * 32, args.in[14], g, tid, wave, lane);
                if (L + G < NU3) P3A_PREFETCH(L + G);
                p3a_sgu_finish(lds, UG, GU0, args.in[12], args.in[13], args.in[15], g, wave, lane);
                continue; }
            const int u = L - 512; int bh, j;
            if (u < 512) { bh = u >> 6; j = (u & 63) + 2; } else { const int cu = u - 512; bh = cu >> 1; j = cu & 1; }
            const int h = bh & 3; const float lgf = -log1pf(expf(-decf[h])), lgb = -log1pf(expf(-decb[h]));
            p3a_kv_fill(lds, A0, A1, K0, K1, lgf, lgb, wave, lane);
            if (L + G < NU3) P3A_PREFETCH(L + G);
            p3a_kv_finish(lds, st_slot(ws, 0, bh, j), st_slot(ws, 1, bh, j), wave, lane);
        }
#undef P3A_PREFETCH
        if (BOTH(3)) xcd_barrier(bar); STAMP(3 + 1);
    }
    if (PHON(4) && IN(4)) {
        for (int gt = gw * 64 + lane; gt < 131072; gt += NGW * 64) p3b_scan(ws, args.in[8], args.in[9], gt);
        if (BOTH(4)) xcd_barrier(bar); STAMP(4 + 1);
    }
    if (PHON(5) && IN(5)) {
        const float* decf = args.in[8]; const float* decb = args.in[9];
        for (int u = vcu; u < 512; u += G) {
            const int bh = u >> 6, n = u & 63, h = bh & 3; const size_t r0 = (size_t)(bh >> 2) * T + (size_t)n * 128;
            const float lgf = -log1pf(expf(-decf[h])), lgb = -log1pf(expf(-decb[h]));
            p3c_unit(lds, (const bf16*)(ws + WS_Q) + (size_t)u * 16384, (const bf16*)(ws + WS_K) + (size_t)u * 16384, (const bf16*)(ws + WS_V) + (size_t)u * 32768,
                     st_slot(ws, 0, bh, n + 2), st_slot(ws, 1, bh, n + 2), (bf16*)(ws + WS_SG) + r0 * 1024 + h * 256, args.in[10] + h * 256, args.in[11] + h * 256, lgf, lgb, tid, wave, lane);
        }
        if (BOTH(5)) xcd_barrier(bar); STAMP(5 + 1);
    }

    if (PHON(6) && IN(6)) {
        pg8::SchedY S; S.init(M, D, G, (int)blockIdx.x, ws + WS_SG, ws + WS_WPA, ws + WS_GU, ws + WS_WPB);
        pg8::EpiY E{(const bf16*)(ws + WS_SGA), (const bf16*)(ws + WS_SGB), (bf16*)(ws + WS_Y)};
        pg8::gemm_phase<pg8::EpiY, pg8::SchedY, true, true>(lds + RING_OFF, D, S, E);
        if (BOTH(6)) xcd_barrier(bar); STAMP(6 + 1);
    }
    if (PHON(7) && IN(7)) {
        pg8::SchedN S; S.init(M, D, G, (int)blockIdx.x, ws + WS_Y, ws + WS_WO);
        pg8::EpiMix E{args.in[0], (const float*)(ws + WS_MOD), args.in[19], (float*)(ws + WS_X1)};
        pg8::gemm_phase<pg8::EpiMix, pg8::SchedN, true, true>(lds + RING_OFF, D, S, E);
        if (BOTH(7)) xcd_barrier(bar); STAMP(7 + 1);
    }
    if (PHON(8) && IN(8)) {
        LAS unsigned char* WH = lds + RING_OFF; LAS unsigned char* WL = lds + RING_OFF + 32768;
        { f32x4 wv[8];
#pragma unroll
          for (int i = 0; i < 8; ++i) wv[i] = *((const GAS f32x4*)args.in[22] + tid + 512 * i);
#pragma unroll
          for (int i = 0; i < 8; ++i) { const int f4 = tid + 512 * i, kk = f4 >> 2, e0 = (f4 & 3) * 4;
#pragma unroll
              for (int j = 0; j < 4; ++j) { const float w = wv[i][j]; const unsigned hl = pk2(w, 0.f) & 0xffffu; const float lo = w - __builtin_bit_cast(float, hl << 16);
                  const int off = rimg(e0 + j, kk >> 3) + 2 * (kk & 7);
                  *(LAS bf16*)(WH + off) = (bf16)hl; *(LAS bf16*)(WL + off) = (bf16)(pk2(lo, 0.f) & 0xffffu); } } }
        const float* MOD = (const float*)(ws + WS_MOD);
        LAS float* par = (LAS float*)(lds + RING_OFF + 65536);
        { const int b = (gw - wave) * (M / (G * NWAVES)) >> 13; const float* sh2 = MOD + b * 6144 + 3 * D; const float* sc2 = MOD + b * 6144 + 4 * D;
          for (int i = tid; i < 1024; i += NWAVES * 64) { par[i] = args.in[20][i]; par[1024 + i] = args.in[21][i]; par[2048 + i] = sc2[i] + 1.f; par[3072 + i] = sh2[i]; } }
        __syncthreads();
        bf16x8 bh[4], bl[4];
#pragma unroll
        for (int ks = 0; ks < 4; ++ks) { const int c = 16 * wave + 4 * ks + (lane >> 4); bh[ks] = *(const LAS bf16x8*)(WH + rimg(lane & 15, c)); bl[ks] = *(const LAS bf16x8*)(WL + rimg(lane & 15, c)); }
        __syncthreads();
        const int rpw = M / (G * NWAVES);
        { const int m = gw * rpw; const int b = m >> 13;
            p4c_rows(rpw, (const float*)(ws + WS_X1) + (size_t)m * D, (float*)(ws + WS_LN1S) + 2 * m, (bf16*)(ws + WS_H2) + (size_t)m * D, (float*)(ws + WS_AFFT) + (size_t)b * 16 * T, m & (T - 1), par,
                     lds + RING_OFF, bh, bl, args.in[23], wave, lane); }
        __syncthreads();
        if (BOTH(8)) xcd_barrier(bar); STAMP(8 + 1);
    }

    if (PHON(9) && IN(9)) {
        const int ntk = G > 64 ? 32 : 0;
        for (int be = vcu; be < 32; be += G) {
            p5_topk(lds, (const float*)(ws + WS_AFFT) + (size_t)be * T, (int*)(ws + WS_IDX) + be * 1024, (float*)(ws + WS_GATEW) + be * 1024, (int*)(ws + WS_SLOT) + (size_t)be * T, tid, wave, lane);
            __syncthreads(); }
        if (vcu >= ntk) {
            LAS float* scr = (LAS float*)(lds + RING_OFF + wave * 16384);
            const unsigned* cprog = (const unsigned*)(ws + WS_CTL) + 2048;
            const int pw = (vcu - ntk) * NWAVES + wave, NP = (G - ntk) * NWAVES; int kd_ = 0;
            const int ka = G == 256 ? CS_P2 : CS_ITEMS, kb = G == 256 ? CS_GU : CS_ITEMS;
            if (NP >= NCS) { const int w = pw % NCS, q = pw / NCS, nq = (NP - 1 - w) / NCS + 1;
                MOE_COPY_STREAM(w, NCS, (int)cprog[w] + q, nq, ka, false, kd_);
                MOE_COPY_STREAM(w, NCS, kb + q, nq, CS_ITEMS, false, kd_); }
            else for (int w = pw; w < NCS; w += NP) { MOE_COPY_STREAM(w, NCS, (int)cprog[w], 1, ka, false, kd_); MOE_COPY_STREAM(w, NCS, kb, 1, CS_ITEMS, false, kd_); }
            (void)kd_;
        }
        if (BOTH(9)) xcd_barrier(bar); STAMP(9 + 1);
    }
    if (PHON(10) && IN(10)) {
        pg8::SchedG1 S; S.init(G, vcu, ws + WS_H2, args.out, (const int*)(ws + WS_IDX));
        pg8::EpiH E{(bf16*)(ws + WS_HID)};
        pg8::gemm_phase<pg8::EpiH, pg8::SchedG1, true, true>(lds + RING_OFF, D, S, E);
        if (BOTH(10)) xcd_barrier(bar); STAMP(10 + 1);
    }
    if (PHON(11) && IN(11)) {
        pg8::SchedG2 S; S.init(G, vcu, ws + WS_HID, ws + WS_WD);
        pg8::EpiYE E{(bf16*)(ws + WS_YE), (const float*)(ws + WS_GATEW)};
        pg8::gemm_phase<pg8::EpiYE, pg8::SchedG2, true, true>(lds + RING_OFF, D, S, E);
        if (BOTH(11)) xcd_barrier(bar); STAMP(11 + 1);
    }
    if (PHON(12) && IN(12)) {
        const float* MOD = (const float*)(ws + WS_MOD);
        { int m = gw * 2; int sl0 = -1, sl1 = -1;
          if (m < M) { const int* sb = (const int*)(ws + WS_SLOT) + (size_t)(m >> 13) * 16 * T + (m & (T - 1)); sl0 = sb[(size_t)(lane & 15) * T]; sl1 = sb[(size_t)(lane & 15) * T + 1]; }
#pragma unroll 1
          for (; m < M; m += NGW * 2) { const int b = m >> 13, mn = m + NGW * 2; int nsl0 = -1, nsl1 = -1;
            if (mn < M) { const int* sb = (const int*)(ws + WS_SLOT) + (size_t)(mn >> 13) * 16 * T + (mn & (T - 1)); nsl0 = sb[(size_t)(lane & 15) * T]; nsl1 = sb[(size_t)(lane & 15) * T + 1]; }
            p8_rows2((const float*)(ws + WS_X1) + (size_t)m * D, (const float*)(ws + WS_LN1S) + 2 * m, args.in[20], args.in[21], args.out + (size_t)m * D, (const bf16*)(ws + WS_YE), sl0, sl1, b, MOD + b * 6144 + 5 * D, args.in[27], args.in[28], lane);
            sl0 = nsl0; sl1 = nsl1; } }
#ifdef DIAG_A
        xcd_barrier(bar); STAMP(13); xcd_barrier(bar);
        { __syncthreads(); const unsigned long long* ts = (const unsigned long long*)(ws + 768 * 1024);
          const float da = (float)(__hip_atomic_load(ts + DIAG_A + 1, __ATOMIC_RELAXED, __HIP_MEMORY_SCOPE_AGENT) - __hip_atomic_load(ts + DIAG_A, __ATOMIC_RELAXED, __HIP_MEMORY_SCOPE_AGENT)) * 0.01f;
          const float db = (float)(__hip_atomic_load(ts + DIAG_B + 1, __ATOMIC_RELAXED, __HIP_MEMORY_SCOPE_AGENT) - __hip_atomic_load(ts + DIAG_B, __ATOMIC_RELAXED, __HIP_MEMORY_SCOPE_AGENT)) * 0.01f;
          const int rpw8 = M / (G * NWAVES);
          for (int m = gw; m < M; m += NGW) { GAS f32x4* xr = (GAS f32x4*)(args.out + (size_t)m * D) + lane;
              for (int j = 0; j < 4; ++j) { f32x4 v = xr[64 * j]; v = v * (1.f + da * DIAG_SCALE); (void)db; xr[64 * j] = v; } } (void)rpw8; }
#endif
    }
#undef IN
#undef BOTH
}

namespace nv {
constexpr float KSCALE = 0.08838834764831845f;
__device__ __forceinline__ float sigmoidf_(float x) { return 1.f / (1.f + expf(-x)); }
__device__ __forceinline__ float siluf_(float x) { return x * sigmoidf_(x); }

__global__ void k_rowln(const float* xin, const float* add, const float* gate, const float* lw, const float* lb,
                        float* out1, const float* sh, const float* sc, float* out2, float alpha, int rows) {
  int row = (blockIdx.x * blockDim.x + threadIdx.x) >> 6; int lane = threadIdx.x & 63;
  if (row >= rows) return;
  float v[16]; float s = 0.f;
#pragma unroll
  for (int i = 0; i < 16; ++i) { int cidx = lane + 64 * i; float t = alpha * xin[(size_t)row * D + cidx]; if (add) t += gate[cidx] * add[(size_t)row * D + cidx]; v[i] = t; s += t; }
  float mean = wave_sum(s) * (1.f / D); float q = 0.f;
#pragma unroll
  for (int i = 0; i < 16; ++i) { v[i] -= mean; q += v[i] * v[i]; }
  float rstd = rsqrtf(wave_sum(q) * (1.f / D) + LN_EPS);
#pragma unroll
  for (int i = 0; i < 16; ++i) { int cidx = lane + 64 * i; float y = v[i] * rstd; if (lw) y = y * lw[cidx] + lb[cidx];
    if (out1) out1[(size_t)row * D + cidx] = y; if (out2) out2[(size_t)row * D + cidx] = y * (1.f + sc[cidx]) + sh[cidx]; }
}
struct EpiStore { float* C; int ldc; int pad; const float* bias; long cBatch;
  __device__ void operator()(int z, int m, int n, float v) const { C[z * cBatch + (size_t)m * ldc + n] = v + (bias ? bias[n] : 0.f); } };
struct EpiGate2 { float* Y; const bf16* SGx; int accumulate; int pad;
  __device__ void operator()(int z, int m, int n, float v) const { float r = bf2f(SGx[(size_t)m * D + n]) * v; if (accumulate) r += Y[(size_t)m * D + n]; Y[(size_t)m * D + n] = r; } };
__device__ __forceinline__ float4 ld_a4(const float* p) { return *(const float4*)p; }
__device__ __forceinline__ float4 ld_a4(const bf16* p) { const uint2 u = *(const uint2*)p; return make_float4(bf2f((bf16)(u.x & 0xffff)), bf2f((bf16)(u.x >> 16)), bf2f((bf16)(u.y & 0xffff)), bf2f((bf16)(u.y >> 16))); }
template <class Epi, class AT>
__global__ __launch_bounds__(256) void ngemm(const AT* __restrict__ A, const int* __restrict__ gidx, const float* __restrict__ Bm,
                                             long aBatch, long bBatch, Epi epi, int lda, int ldb, int K, int gBatch) {
  __shared__ float As[16][68];
  __shared__ float Bs[16][68];
  const int z = blockIdx.z; A += z * aBatch; Bm += z * bBatch; if (gidx) gidx += z * gBatch;
  const int tid = threadIdx.x, tx = tid & 15, ty = tid >> 4;
  const int m0 = blockIdx.y * 64, n0 = blockIdx.x * 64;
  float acc[4][4];
#pragma unroll
  for (int i = 0; i < 4; ++i)
#pragma unroll
    for (int j = 0; j < 4; ++j) acc[i][j] = 0.f;
  const int ar = tid >> 2, ak = (tid & 3) * 4;
  const long arow = gidx ? (long)gidx[m0 + ar] : (long)(m0 + ar);
  const AT* ap = A + arow * lda + ak;
  const int bk = tid >> 4, bn = (tid & 15) * 4;
  const float* bp = Bm + (long)bk * ldb + n0 + bn;
  for (int k0 = 0; k0 < K; k0 += 16) {
    const float4 av = ld_a4(ap + k0);
    const float4 bv = *(const float4*)(bp + (long)k0 * ldb);
    As[ak + 0][ar] = av.x; As[ak + 1][ar] = av.y; As[ak + 2][ar] = av.z; As[ak + 3][ar] = av.w;
    *(float4*)&Bs[bk][bn] = bv;
    __syncthreads();
#pragma unroll
    for (int kk = 0; kk < 16; ++kk) {
      const float4 a = *(const float4*)&As[kk][ty * 4]; const float4 b = *(const float4*)&Bs[kk][tx * 4];
      const float aa[4] = {a.x, a.y, a.z, a.w}; const float bb[4] = {b.x, b.y, b.z, b.w};
#pragma unroll
      for (int i = 0; i < 4; ++i)
#pragma unroll
        for (int j = 0; j < 4; ++j) acc[i][j] += aa[i] * bb[j];
    }
    __syncthreads();
  }
#pragma unroll
  for (int i = 0; i < 4; ++i)
#pragma unroll
    for (int j = 0; j < 4; ++j) epi(z, m0 + ty * 4 + i, n0 + tx * 4 + j, acc[i][j]);
}
__global__ void k_ctx_state2(const bf16* KC, const bf16* VC, const float* decf, const float* decb, float* S0) {
  int idx = blockIdx.x * blockDim.x + threadIdx.x;
  int v = idx & 255, d = (idx >> 8) & 127, h = (idx >> 15) & 3, b = (idx >> 17) & 1, dir = idx >> 18;
  if (dir >= 2) return;
  float dec = dir == 0 ? decf[h] : decb[h]; float lg = -log1pf(expf(-dec));
  float acc = 0.f;
  for (int t = 0; t < CTXL; ++t) {
    float w = expf((dir == 0 ? (float)(CTXL - 1 - t) : (float)t) * lg);
    acc += w * bf2f(KC[(size_t)(b * CTXL + t) * 512 + h * 128 + d]) * bf2f(VC[(size_t)(b * CTXL + t) * 1024 + h * 256 + v]);
  }
  S0[idx] = acc;
}
__global__ __launch_bounds__(256) void k_ret_rec2(const bf16* Q, const bf16* K, const bf16* V, const float* S0, const float* decf, const float* decb, float* OF, float* OB, int b, int pad) {
  __shared__ float qs[32][128]; __shared__ float ks[32][128];
  int h = blockIdx.x & 3, dir = blockIdx.x >> 2; int j = threadIdx.x;
  float dec = dir == 0 ? decf[h] : decb[h]; float gamma = 1.f / (1.f + expf(-dec));
  float S[128];
  const float* s0 = S0 + ((size_t)((dir * 2 + b) * 4 + h) * 128) * 256;
#pragma unroll
  for (int d = 0; d < 128; ++d) S[d] = s0[d * 256 + j];
  float* O = dir == 0 ? OF : OB;
  const size_t rb = (size_t)b * T;
  for (int blk = 0; blk < T / 32; ++blk) {
    int tb = dir == 0 ? blk * 32 : T - 32 - blk * 32;
    __syncthreads();
    for (int i = threadIdx.x; i < 32 * 128; i += 256) { int tt = i >> 7, d = i & 127; qs[tt][d] = bf2f(Q[(rb + tb + tt) * 512 + h * 128 + d]); ks[tt][d] = bf2f(K[(rb + tb + tt) * 512 + h * 128 + d]); }
    __syncthreads();
    for (int s = 0; s < 32; ++s) {
      int tt = dir == 0 ? s : 31 - s; int t = tb + tt;
      float vj = bf2f(V[(rb + t) * 1024 + h * 256 + j]);
      float o = 0.f;
#pragma unroll
      for (int d = 0; d < 128; ++d) { S[d] = gamma * S[d] + ks[tt][d] * vj; o += qs[tt][d] * S[d]; }
      O[(size_t)t * D + h * 256 + j] = o;
    }
  }
}
__global__ void k_ret_fin2(const float* OF, const float* OB, const bf16* SGb, const float* gw, const float* gb, float* RET) {
  int w = (blockIdx.x * blockDim.x + threadIdx.x) >> 6; int lane = threadIdx.x & 63;
  if (w >= T * 4) return; int t = w >> 2, h = w & 3;
  float v[4]; float s = 0.f;
#pragma unroll
  for (int i = 0; i < 4; ++i) { int cidx = h * 256 + lane + 64 * i; v[i] = OF[(size_t)t * D + cidx] + OB[(size_t)t * D + cidx]; s += v[i]; }
  float mean = wave_sum(s) * (1.f / 256); float q = 0.f;
#pragma unroll
  for (int i = 0; i < 4; ++i) { v[i] -= mean; q += v[i] * v[i]; }
  float rstd = rsqrtf(wave_sum(q) * (1.f / 256) + LN_EPS);
#pragma unroll
  for (int i = 0; i < 4; ++i) { int cidx = h * 256 + lane + 64 * i; float y = v[i] * rstd * gw[cidx] + gb[cidx]; RET[(size_t)t * D + cidx] = y * bf2f(SGb[(size_t)t * D + cidx]); }
}
__global__ void k_gv2(const bf16* GVSb, const float* lw, const float* lb, float* GV) {
  int row = (blockIdx.x * blockDim.x + threadIdx.x) >> 6; int lane = threadIdx.x & 63;
  if (row >= T) return;
  float v[16]; float s = 0.f;
#pragma unroll
  for (int i = 0; i < 16; ++i) { v[i] = bf2f(GVSb[(size_t)row * D + lane + 64 * i]); s += v[i]; }
  float mean = wave_sum(s) * (1.f / D); float q = 0.f;
#pragma unroll
  for (int i = 0; i < 16; ++i) { v[i] -= mean; q += v[i] * v[i]; }
  float rstd = rsqrtf(wave_sum(q) * (1.f / D) + LN_EPS);
#pragma unroll
  for (int i = 0; i < 16; ++i) { int cidx = lane + 64 * i; GV[(size_t)row * D + cidx] = v[i] * rstd * lw[cidx] + lb[cidx]; }
}
__global__ void k_sgu2(const bf16* GUb, const float* GV, const float* sw, const float* sb, float* SGU) {
  int idx = blockIdx.x * blockDim.x + threadIdx.x; int ch = idx & 1023, t = idx >> 10;
  if (t >= T) return; int n = t >> 7, p = t & 127, g = ch >> 8;
  const float* wrow = sw + ((size_t)g * 128 + p) * 128; float acc = 0.f;
  for (int q = 0; q < 128; ++q) acc += wrow[q] * GV[(size_t)(n * 128 + q) * D + ch];
  acc += sb[g * 128 + p];
  SGU[(size_t)t * D + ch] = bf2f(GUb[(size_t)t * D + ch]) * acc;
}
__global__ void k_router(const float* H2, const float* wr, const float* br, float* AFF) {
  int row = (blockIdx.x * blockDim.x + threadIdx.x) >> 6; int lane = threadIdx.x & 63;
  if (row >= T) return;
  float acc[NE];
#pragma unroll
  for (int e = 0; e < NE; ++e) acc[e] = 0.f;
  for (int i = 0; i < 16; ++i) { int k = lane + 64 * i; float hv = H2[(size_t)row * D + k];
#pragma unroll
    for (int e = 0; e < NE; ++e) acc[e] += hv * wr[k * NE + e]; }
  float mx = -1e30f;
#pragma unroll
  for (int e = 0; e < NE; ++e) { acc[e] = wave_sum(acc[e]) + br[e]; mx = fmaxf(mx, acc[e]); }
  float sum = 0.f;
#pragma unroll
  for (int e = 0; e < NE; ++e) { acc[e] = expf(acc[e] - mx); sum += acc[e]; }
  if (lane < NE) { float o = 0.f;
#pragma unroll
    for (int e = 0; e < NE; ++e) if (e == lane) o = acc[e];
    AFF[(size_t)row * NE + lane] = o / sum; }
}
__global__ void k_topk(const float* AFF, int* IDX, float* GATE) {
  int idx = blockIdx.x * blockDim.x + threadIdx.x; int t = idx & (T - 1), e = idx >> 13;
  if (e >= NE) return;
  float a = AFF[(size_t)t * NE + e]; int rank = 0;
  for (int s = 0; s < T; ++s) { float o = AFF[(size_t)s * NE + e]; rank += (o > a) || (o == a && s < t); }
  if (rank < CAP) { IDX[e * CAP + rank] = t; GATE[e * CAP + rank] = a; }
}
__global__ void k_hidden(float* G1, const float* U1, size_t n) { size_t i = (size_t)blockIdx.x * blockDim.x + threadIdx.x; if (i < n) G1[i] = siluf_(G1[i]) * U1[i]; }
__global__ void k_zero(float* p, size_t n) { size_t i = (size_t)blockIdx.x * blockDim.x + threadIdx.x; if (i < n) p[i] = 0.f; }
__global__ void k_scatter(const float* YE, const int* IDX, const float* GATE, float* MOE) {
  size_t i = (size_t)blockIdx.x * blockDim.x + threadIdx.x; if (i >= (size_t)NE * CAP * D) return;
  int d = i & 1023; int es = i >> 10; atomicAdd(&MOE[(size_t)IDX[es] * D + d], YE[i] * GATE[es]);
}
}

extern "C" void kernel_launch(void* const* d_in, const int* in_sizes, int n_in, void* d_out, int out_size, void* d_ws, size_t ws_size, hipStream_t stream) {
  static int grid = 0;
  if (grid == 0) {
    if (n_in != 29 || out_size != M * D || ws_size < WS_END) { fprintf(stderr, "kernel_launch: unexpected shapes / workspace (%d inputs, out %d, ws %zu)\n", n_in, out_size, ws_size); grid = -1; return; }
    int dev = 0, cus = 0, per_cu = 0;
    if (hipGetDevice(&dev) != hipSuccess || hipDeviceGetAttribute(&cus, hipDeviceAttributeMultiprocessorCount, dev) != hipSuccess) { grid = -1; return; }
    if (hipFuncSetAttribute((const void*)mk_fwd, hipFuncAttributeMaxDynamicSharedMemorySize, LDS_BYTES) != hipSuccess) { fprintf(stderr, "kernel_launch: hipFuncSetAttribute failed\n"); grid = -1; return; }
    if (hipOccupancyMaxActiveBlocksPerMultiprocessor(&per_cu, (const void*)mk_fwd, NWAVES * 64, LDS_BYTES) != hipSuccess || per_cu < 1) fprintf(stderr, "kernel_launch: occupancy query says %d\n", per_cu);
    (void)hipGetLastError();
    grid = cus;
  }
  if (grid < 0) return;
  using namespace nv;
  if (hipMemsetAsync((char*)d_ws + WS_CTL, 0, CTL_ZERO_BYTES, stream) != hipSuccess) return;
  Args a{};
  for (int i = 0; i < 29; ++i) a.in[i] = (const float*)d_in[i];
  a.out = (float*)d_out; a.ws = (unsigned char*)d_ws; a.ph_lo = 0; a.ph_hi = 13; a.li = 0; a.pad = 0;
  hipLaunchKernelGGL(mk_fwd, dim3(grid), dim3(NWAVES * 64), LDS_BYTES, stream, a);

}
```
